# Optimizing an MI355X kernel written in HIP

```python
import math
import jax
import jax.numpy as jnp
from jax import lax
import numpy as np


D_MODEL = 1024
BATCH = 2
SEQ = 8192
DEPTH = 1

N_HEADS = 8
HEAD_DIM = 64
ATTN_WIDTH = N_HEADS * HEAD_DIM
MOBA_BLOCK = 256
MOBA_TOPK = 3
Q_CHUNK = 128
CONV_WIDTH = D_MODEL // 2
CONV_K = 3
N_BRANCHES = 2
D_IN = 3 * ATTN_WIDTH + 3 * CONV_WIDTH + N_BRANCHES * D_MODEL
N_BUCKETS = 32
MAX_EXACT = N_BUCKETS // 2
MAX_DISTANCE = 128
N_GROUPS = 4
EXPERTS_PER_GROUP = 8
N_EXPERTS = N_GROUPS * EXPERTS_PER_GROUP
TOP_K_EXPERTS = 2
D_EXPERT = D_MODEL // 2
EXPERT_BLOCK = 128
N_MOD = 6
NORM_EPS = 1e-6
NEG_INF = -1e30

kernel_name = 'hybrid_moba_shortconv_hmoe_block'


def rms_norm(x, g):
    xf = x.astype(jnp.float32)
    y = xf * lax.rsqrt(jnp.mean(xf * xf, axis=-1, keepdims=True) + NORM_EPS)
    return y.astype(x.dtype) * g


def rel_bucket(dist):
    n = jnp.maximum(dist, 0)
    nf = jnp.maximum(n, 1).astype(jnp.float32)
    large = MAX_EXACT + (jnp.log(nf / MAX_EXACT) / math.log(MAX_DISTANCE / MAX_EXACT)
                         * (N_BUCKETS - MAX_EXACT)).astype(jnp.int32)
    large = jnp.minimum(large, N_BUCKETS - 1)
    return jnp.where(n < MAX_EXACT, n, large)


def moba_attention(q, k, v, rel_bias):
    B, S, H, Dh = q.shape
    Sp = -(-S // MOBA_BLOCK) * MOBA_BLOCK
    pad = ((0, 0), (0, Sp - S), (0, 0), (0, 0))
    q = jnp.pad(q, pad)
    k = jnp.pad(k, pad)
    v = jnp.pad(v, pad)
    nb = Sp // MOBA_BLOCK
    tk = max(1, min(MOBA_TOPK, nb - 1))
    scale = HEAD_DIM ** -0.5

    kb = k.reshape(B, nb, MOBA_BLOCK, H, Dh)
    vb = v.reshape(B, nb, MOBA_BLOCK, H, Dh)
    k_mean = jnp.mean(kb.astype(jnp.float32), axis=2)
    q_block = jnp.arange(Sp) // MOBA_BLOCK
    gate = jnp.einsum('bshd,bnhd->bshn', q.astype(jnp.float32), k_mean)
    past = jnp.arange(nb)[None, :] < q_block[:, None]
    gate = jnp.where(past[None, :, None, :], gate, NEG_INF)
    _, sel = lax.top_k(gate, tk)
    sel_valid = sel < q_block[None, :, None, None]

    k_blocks = kb.transpose(0, 3, 1, 2, 4)
    v_blocks = vb.transpose(0, 3, 1, 2, 4)
    b_ix = jnp.arange(B)[:, None, None, None]
    h_ix = jnp.arange(H)[None, None, :, None]
    key_off = jnp.arange(MOBA_BLOCK)
    n_chunks = Sp // Q_CHUNK

    def to_chunks(t):
        return jnp.moveaxis(t.reshape(B, n_chunks, Q_CHUNK, *t.shape[2:]), 1, 0)

    def chunk_attn(args):
        ci, qc, sc, vc = args
        q_pos = ci * Q_CHUNK + jnp.arange(Q_CHUNK)
        k_sel = k_blocks[b_ix, h_ix, sc]
        v_sel = v_blocks[b_ix, h_ix, sc]
        kpos_sel = sc[..., None] * MOBA_BLOCK + key_off
        bias_sel = rel_bias[rel_bucket(q_pos[None, :, None, None, None] - kpos_sel), h_ix[..., None]]
        s_sel = jnp.einsum('bqhd,bqhtkd->bqhtk', qc, k_sel).astype(jnp.float32) * scale + bias_sel
        s_sel = jnp.where(vc[..., None], s_sel, NEG_INF).reshape(B, Q_CHUNK, H, tk * MOBA_BLOCK)
        start = (ci * Q_CHUNK // MOBA_BLOCK) * MOBA_BLOCK
        k_own = lax.dynamic_slice_in_dim(k, start, MOBA_BLOCK, axis=1)
        v_own = lax.dynamic_slice_in_dim(v, start, MOBA_BLOCK, axis=1)
        dist = q_pos[:, None] - (start + key_off)[None, :]
        bias_own = jnp.transpose(rel_bias[rel_bucket(dist)], (0, 2, 1))
        s_own = jnp.einsum('bqhd,bkhd->bqhk', qc, k_own).astype(jnp.float32) * scale + bias_own[None]
        s_own = jnp.where((dist >= 0)[None, :, None, :], s_own, NEG_INF)
        p = jax.nn.softmax(jnp.concatenate([s_sel, s_own], axis=-1), axis=-1).astype(v.dtype)
        p_sel = p[..., :tk * MOBA_BLOCK].reshape(B, Q_CHUNK, H, tk, MOBA_BLOCK)
        p_own = p[..., tk * MOBA_BLOCK:]
        return (jnp.einsum('bqhtk,bqhtkd->bqhd', p_sel, v_sel)
                + jnp.einsum('bqhk,bkhd->bqhd', p_own, v_own))

    out = lax.map(chunk_attn, (jnp.arange(n_chunks), to_chunks(q), to_chunks(sel), to_chunks(sel_valid)))
    return jnp.moveaxis(out, 0, 1).reshape(B, Sp, H, Dh)[:, :S]


def short_conv(cg, bg, xv, w_conv):
    u = cg * xv
    S = u.shape[1]
    up = jnp.pad(u, ((0, 0), (CONV_K - 1, 0), (0, 0)))
    y = sum(w_conv[j] * up[:, j:j + S] for j in range(CONV_K))
    return bg * y


def hierarchical_moe(h2d, w_rg, b_rg, w_re, b_re, w_gate, w_up, w_down):
    T, D = h2d.shape
    hf = h2d.astype(jnp.float32)
    g_logits = hf @ w_rg.astype(jnp.float32) + b_rg.astype(jnp.float32)
    g_prob = jax.nn.softmax(g_logits, axis=-1)
    g_sel = jnp.argmax(g_logits, axis=-1).astype(jnp.int32)
    g_w = jnp.take_along_axis(g_prob, g_sel[:, None], axis=-1)
    e_logits = (hf @ w_re.astype(jnp.float32) + b_re.astype(jnp.float32)).reshape(T, N_GROUPS, EXPERTS_PER_GROUP)
    e_logits = jnp.take_along_axis(e_logits, g_sel[:, None, None], axis=1)[:, 0]
    e_prob = jax.nn.softmax(e_logits, axis=-1)
    top_p, top_i = lax.top_k(e_prob, TOP_K_EXPERTS)
    weights = top_p / jnp.sum(top_p, axis=-1, keepdims=True) * g_w
    expert = g_sel[:, None] * EXPERTS_PER_GROUP + top_i.astype(jnp.int32)

    A = T * TOP_K_EXPERTS
    a_e = expert.reshape(A)
    a_w = weights.reshape(A)
    a_tok = jnp.repeat(jnp.arange(T, dtype=jnp.int32), TOP_K_EXPERTS)
    order = jnp.argsort(a_e)
    e_s = a_e[order]
    tok_s = a_tok[order]
    w_s = a_w[order]
    counts = jnp.bincount(a_e, length=N_EXPERTS).astype(jnp.int32)
    starts = jnp.cumsum(counts) - counts
    padded = (counts + EXPERT_BLOCK - 1) // EXPERT_BLOCK * EXPERT_BLOCK
    pends = jnp.cumsum(padded)
    pstarts = pends - padded
    dest = pstarts[e_s] + jnp.arange(A, dtype=jnp.int32) - starts[e_s]
    n_blk = -(-A // EXPERT_BLOCK) + N_EXPERTS
    buf = jnp.zeros((n_blk * EXPERT_BLOCK, D), h2d.dtype).at[dest].set(h2d[tok_s])
    blk_e = jnp.minimum(jnp.searchsorted(pends, jnp.arange(n_blk, dtype=jnp.int32) * EXPERT_BLOCK,
                                         side='right'), N_EXPERTS - 1)

    def expert_ffn(args):
        xb, e = args
        return (jax.nn.silu(xb @ w_gate[e]) * (xb @ w_up[e])) @ w_down[e]

    out = lax.map(expert_ffn, (buf.reshape(n_blk, EXPERT_BLOCK, D), blk_e)).reshape(-1, D)
    contrib = (out[dest] * w_s[:, None]).astype(h2d.dtype)
    return jnp.zeros_like(h2d).at[tok_s].add(contrib)


def setup_inputs(seed: int = 0) -> dict:
    key = jax.random.key(seed)
    ks = jax.random.split(key, 21)
    f32 = jnp.float32

    def nrm(k, shape, scale):
        return jax.random.normal(k, shape, f32) * scale

    return {
        'x': nrm(ks[0], (BATCH, SEQ, D_MODEL), 1.0),
        'c': nrm(ks[1], (BATCH, D_MODEL), 1.0),
        'rel_bias': nrm(ks[2], (N_BUCKETS, N_HEADS), 0.5),
        'norm1_g': 1.0 + nrm(ks[3], (DEPTH, D_MODEL), 0.02),
        'norm2_g': 1.0 + nrm(ks[4], (DEPTH, D_MODEL), 0.02),
        'w_ada': nrm(ks[5], (DEPTH, D_MODEL, N_MOD * D_MODEL), 0.5 * D_MODEL ** -0.5),
        'b_ada': nrm(ks[6], (DEPTH, N_MOD * D_MODEL), 0.02),
        'w_in': nrm(ks[7], (DEPTH, D_MODEL, D_IN), D_MODEL ** -0.5),
        'b_gate': nrm(ks[8], (DEPTH, N_BRANCHES * D_MODEL), 0.02),
        'conv_w': nrm(ks[9], (DEPTH, CONV_K, CONV_WIDTH), CONV_K ** -0.5),
        'w_attn_out': nrm(ks[10], (DEPTH, ATTN_WIDTH, D_MODEL), ATTN_WIDTH ** -0.5),
        'w_conv_out': nrm(ks[11], (DEPTH, CONV_WIDTH, D_MODEL), CONV_WIDTH ** -0.5),
        'w_o': nrm(ks[12], (DEPTH, D_MODEL, D_MODEL), D_MODEL ** -0.5),
        'w_router_group': nrm(ks[13], (DEPTH, D_MODEL, N_GROUPS), D_MODEL ** -0.5),
        'b_router_group': nrm(ks[14], (DEPTH, N_GROUPS), 0.01),
        'w_router_expert': nrm(ks[15], (DEPTH, D_MODEL, N_EXPERTS), D_MODEL ** -0.5),
        'b_router_expert': nrm(ks[16], (DEPTH, N_EXPERTS), 0.01),
        'w_exp_gate': nrm(ks[17], (DEPTH, N_EXPERTS, D_MODEL, D_EXPERT), D_MODEL ** -0.5),
        'w_exp_up': nrm(ks[18], (DEPTH, N_EXPERTS, D_MODEL, D_EXPERT), D_MODEL ** -0.5),
        'w_exp_down': nrm(ks[19], (DEPTH, N_EXPERTS, D_EXPERT, D_MODEL), D_EXPERT ** -0.5),
        'final_norm_g': 1.0 + nrm(ks[20], (D_MODEL,), 0.02),
    }


def reference(x, c, rel_bias, norm1_g, norm2_g, w_ada, b_ada, w_in, b_gate, conv_w,
              w_attn_out, w_conv_out, w_o, w_router_group, b_router_group,
              w_router_expert, b_router_expert, w_exp_gate, w_exp_up, w_exp_down,
              final_norm_g):
    B, S, D = x.shape
    widths = [ATTN_WIDTH, ATTN_WIDTH, ATTN_WIDTH, CONV_WIDTH, CONV_WIDTH, CONV_WIDTH, D_MODEL, D_MODEL]
    split_at = [int(i) for i in np.cumsum(widths)[:-1]]
    c_act = jax.nn.silu(c)
    for l in range(DEPTH):
        mod = c_act @ w_ada[l] + b_ada[l]
        sh1, sc1, g1, sh2, sc2, g2 = jnp.split(mod, N_MOD, axis=-1)

        h = rms_norm(x, norm1_g[l]) * (1.0 + sc1[:, None]) + sh1[:, None]
        proj = h @ w_in[l]
        q, k, v, cg, bg, xv, gl_a, gl_c = jnp.split(proj, split_at, axis=-1)
        q = q.reshape(B, S, N_HEADS, HEAD_DIM)
        k = k.reshape(B, S, N_HEADS, HEAD_DIM)
        v = v.reshape(B, S, N_HEADS, HEAD_DIM)
        y_attn = moba_attention(q, k, v, rel_bias).reshape(B, S, ATTN_WIDTH) @ w_attn_out[l]
        y_conv = short_conv(cg, bg, xv, conv_w[l]) @ w_conv_out[l]
        b_a, b_c = jnp.split(b_gate[l], N_BRANCHES, axis=-1)
        merged = jax.nn.sigmoid(gl_a + b_a) * y_attn + jax.nn.sigmoid(gl_c + b_c) * y_conv
        x = x + g1[:, None] * (merged @ w_o[l])

        h = rms_norm(x, norm2_g[l]) * (1.0 + sc2[:, None]) + sh2[:, None]
        y = hierarchical_moe(h.reshape(B * S, D), w_router_group[l], b_router_group[l],
                             w_router_expert[l], b_router_expert[l],
                             w_exp_gate[l], w_exp_up[l], w_exp_down[l]).reshape(B, S, D)
        x = x + g2[:, None] * y
    return rms_norm(x, final_norm_g)
```

```cpp
#include <hip/hip_runtime.h>
#include <cstdio>
#include <cstdint>

#define LAS __attribute__((address_space(3)))
#define GAS __attribute__((address_space(1)))
typedef unsigned short bf16_t;
typedef short bf16x8 __attribute__((ext_vector_type(8)));
typedef short s16x4 __attribute__((ext_vector_type(4)));
typedef float f32x4 __attribute__((ext_vector_type(4)));
typedef float f32x16 __attribute__((ext_vector_type(16)));
typedef float f32x2 __attribute__((ext_vector_type(2)));
typedef unsigned u32x4 __attribute__((ext_vector_type(4)));
typedef unsigned u32x2 __attribute__((ext_vector_type(2)));
typedef __bf16 bf16x2_t __attribute__((ext_vector_type(2)));

__device__ __forceinline__ unsigned cvt_pk_bf16(float lo, float hi) { f32x2 v = {lo, hi}; bf16x2_t b = __builtin_convertvector(v, bf16x2_t); return __builtin_bit_cast(unsigned, b); }
__device__ __forceinline__ float bf_lo(unsigned u) { return __builtin_bit_cast(float, u << 16); }
__device__ __forceinline__ float bf_hi(unsigned u) { return __builtin_bit_cast(float, u & 0xffff0000u); }
__device__ __forceinline__ float sigmoidf_(float x) { return __builtin_amdgcn_rcpf(1.f + __expf(-x)); }

namespace pg8 {
constexpr int BM = 256, BK = 64, HALF = 128, HTB = HALF * BK * 2, STAGE_BYTES = 8 * HTB, NXCD = 8, WGM = 8;
__host__ __device__ __forceinline__ int lds_byte(int r, int c) { const int st = (r >> 4) * 2 + (c >> 5), rr = r & 15, cc = c & 31, ob = rr * 64 + cc * 2; return st * 1024 + (ob ^ (((ob >> 9) & 1) << 5)); }
__host__ __device__ __forceinline__ void stage_rc(int b, int& R, int& C) { const int st = b / 1024, sb = b % 1024, swz = sb ^ (((sb >> 9) & 1) << 5); R = (st >> 1) * 16 + swz / 64; C = (st & 1) * 32 + (swz % 64) / 2; }
__host__ __device__ __forceinline__ int perm32(int rho) { const int n = rho >> 4, i = rho & 15; return 8 * (i >> 2) + 4 * n + (i & 3); }

struct Unit { const char* A; const char* B; int pm, pn, e, nvalid; };

struct StaticOrder {
    const char* A; const char* Bt; int K; int nM, nN, nwg, G, c;
    __device__ void init(const void* A_, const void* Bt_, int M, int N, int K_, int G_, int c_) { A = (const char*)A_; Bt = (const char*)Bt_; K = K_; nM = M / BM; nN = N / BM; nwg = nM * nN; G = G_; c = c_; }
    __device__ bool next(int i, Unit& u) const {
        const long L = (long)i * G + c; if (L >= nwg) return false;
        int wgid = (int)L; { const int q = nwg / NXCD, r = nwg % NXCD, xcd = wgid % NXCD, off = wgid / NXCD; wgid = (xcd < r ? xcd * (q + 1) : r * (q + 1) + (xcd - r) * q) + off; }
        const int nig = WGM * nN, gid = wgid / nig, fm = gid * WGM, gsz = (nM - fm) < WGM ? (nM - fm) : WGM;
        u.pm = fm + ((wgid % nig) % gsz); u.pn = (wgid % nig) / gsz; u.e = 0; u.nvalid = 256;
        u.A = A + (size_t)u.pm * 256 * K * 2; u.B = Bt + (size_t)u.pn * 256 * K * 2; return true;
    }
    __device__ __forceinline__ unsigned arow(int, int) const { return 0u; }
};

template <class Epi, class Sched, bool ALIGN_EPI, bool GATHER>
__device__ __forceinline__ void gemm_phase(LAS unsigned char* lds, const int K, const Sched& S, const Epi& E) {
    const int tid = threadIdx.x, wid = __builtin_amdgcn_readfirstlane(tid >> 6), lane = tid & 63, wr = wid >> 2, wc = wid & 3, fr = lane & 15, fq = lane >> 4;
    const int nt = K / BK;
    unsigned voffB[2]; int RA[2], CA[2];
#pragma unroll
    for (int i = 0; i < 2; ++i) { int R, C; stage_rc(tid * 16 + i * 8192, R, C); const int Rb = Epi::PERM ? ((R & ~31) + perm32(R & 31)) : R;
        RA[i] = R; CA[i] = C; voffB[i] = (unsigned)(Rb * K + C) * 2u; }
    const size_t kstep = (size_t)(BK * 2);
    const size_t hstep = (size_t)HALF * K * 2;
    const unsigned ldsw = (unsigned)wid * 1024u;
    const int aoff = lds_byte(wr * 64 + fr, fq * 8), boff = lds_byte(wc * 32 + fr, fq * 8);
#define PG8_SA(b, h) (((b) * 2 + (h)) * HTB)
#define PG8_SB(b, h) ((4 + (b) * 2 + (h)) * HTB)
#define PG8_STAGE(bufoff, gbase, voff) do { _Pragma("unroll") for (int _i = 0; _i < 2; ++_i) \
        __builtin_amdgcn_global_load_lds((const unsigned*)((const char*)(gbase) + (voff)[_i]), (LAS unsigned*)(lds + (bufoff) + ldsw + _i * 8192), 16, 0, 0); } while (0)
#define PG8_LDA(dst, b, h) do { _Pragma("unroll") for (int m = 0; m < 4; ++m) _Pragma("unroll") for (int k = 0; k < 2; ++k) dst[m][k] = *(const LAS bf16x8*)(lds + PG8_SA(b, h) + aoff + m * 2048 + k * 1024); } while (0)
#define PG8_LDB(dst, b, h) do { _Pragma("unroll") for (int n = 0; n < 2; ++n) _Pragma("unroll") for (int k = 0; k < 2; ++k) dst[n][k] = *(const LAS bf16x8*)(lds + PG8_SB(b, h) + boff + n * 2048 + k * 1024); } while (0)
#define PG8_MMA(ai, bj, At, Bt) do { __builtin_amdgcn_s_setprio(1); _Pragma("unroll") for (int m = 0; m < 4; ++m) _Pragma("unroll") for (int n = 0; n < 2; ++n) _Pragma("unroll") for (int k = 0; k < 2; ++k) \
        acc[ai][bj][m][n] = __builtin_amdgcn_mfma_f32_16x16x32_bf16(Bt[n][k], At[m][k], acc[ai][bj][m][n], 0, 0, 0); __builtin_amdgcn_s_setprio(0); } while (0)
#define PG8_WAIT_V(n) asm volatile("s_waitcnt vmcnt(" #n ")" ::: "memory")
#define PG8_WAIT_L(n) asm volatile("s_waitcnt lgkmcnt(" #n ")" ::: "memory")
#define PG8_BAR __builtin_amdgcn_s_barrier()
#define PG8_SCHED __builtin_amdgcn_sched_barrier(0)
    Unit cur, nxt; int ui = 0;
    if (!S.next(0, cur)) return;
    f32x4 acc[2][2][4][2];
#pragma unroll
    for (int a = 0; a < 2; ++a)
#pragma unroll
        for (int b = 0; b < 2; ++b)
#pragma unroll
            for (int m = 0; m < 4; ++m)
#pragma unroll
                for (int n = 0; n < 2; ++n) acc[a][b][m][n] = (f32x4){0.f, 0.f, 0.f, 0.f};
    bf16x8 At[4][2], B0[2][2], B1[2][2];
    unsigned va[2][2], vn[2][2];
#pragma unroll
    for (int h = 0; h < 2; ++h)
#pragma unroll
        for (int i = 0; i < 2; ++i) {
            if constexpr (GATHER) va[h][i] = S.arow(0, h * HALF + RA[i]) * (unsigned)(K * 2) + (unsigned)(CA[i] * 2);
            else va[h][i] = (unsigned)((h * HALF + RA[i]) * K + CA[i]) * 2u;
            vn[h][i] = va[h][i]; }
    const char* cA = cur.A; const char* cB = cur.B;
    PG8_STAGE(PG8_SB(0, 0), cB, voffB); PG8_STAGE(PG8_SB(0, 1), cB + hstep, voffB); PG8_STAGE(PG8_SA(0, 0), cA, va[0]); PG8_STAGE(PG8_SA(0, 1), cA, va[1]);
    if (wr == 1) PG8_BAR;
    PG8_WAIT_V(2); PG8_BAR;
    PG8_STAGE(PG8_SB(1, 0), cB + kstep, voffB); PG8_STAGE(PG8_SA(1, 0), cA + kstep, va[0]); PG8_STAGE(PG8_SB(1, 1), cB + hstep + kstep, voffB);
    PG8_WAIT_V(6); PG8_BAR;
    for (;;) {
        const bool has_next = S.next(ui + 1, nxt);
        const char* nA = has_next ? nxt.A : cA; const char* nB = has_next ? nxt.B : cB;
        if constexpr (GATHER) { if (has_next) {
#pragma unroll
            for (int h = 0; h < 2; ++h)
#pragma unroll
                for (int i = 0; i < 2; ++i) vn[h][i] = S.arow(ui + 1, h * HALF + RA[i]) * (unsigned)(K * 2) + (unsigned)(CA[i] * 2); } }
        for (int t = 0; t < nt; t += 2) {
            const bool last = (t == nt - 2);
            const char* a1 = cA + (size_t)(t + 1) * kstep;
            const char* a2 = last ? nA : cA + (size_t)(t + 2) * kstep; const char* b2 = last ? nB : cB + (size_t)(t + 2) * kstep;
            const char* a3 = a2 + kstep; const char* b3 = b2 + kstep;
            unsigned w0[2], w1[2];
            if constexpr (GATHER) { w0[0] = last ? vn[0][0] : va[0][0]; w0[1] = last ? vn[0][1] : va[0][1]; w1[0] = last ? vn[1][0] : va[1][0]; w1[1] = last ? vn[1][1] : va[1][1]; }
            else { w0[0] = va[0][0]; w0[1] = va[0][1]; w1[0] = va[1][0]; w1[1] = va[1][1]; }
            PG8_LDB(B0, 0, 0); PG8_LDB(B1, 0, 1); PG8_SCHED; PG8_LDA(At, 0, 0); PG8_STAGE(PG8_SA(1, 1), a1, va[1]);
            PG8_WAIT_V(8); PG8_WAIT_L(0); PG8_BAR; PG8_MMA(0, 0, At, B0); PG8_MMA(0, 1, At, B1); PG8_BAR; PG8_SCHED;
            PG8_LDA(At, 0, 1); PG8_STAGE(PG8_SB(0, 0), b2, voffB); PG8_STAGE(PG8_SB(0, 1), b2 + hstep, voffB); PG8_STAGE(PG8_SA(0, 0), a2, w0);
            PG8_WAIT_V(8); PG8_WAIT_L(0); PG8_BAR; PG8_MMA(1, 0, At, B0); PG8_MMA(1, 1, At, B1); PG8_BAR; PG8_SCHED;
            PG8_LDB(B0, 1, 0); PG8_LDB(B1, 1, 1); PG8_SCHED; PG8_LDA(At, 1, 0); PG8_STAGE(PG8_SA(0, 1), a2, w1);
            PG8_WAIT_V(8); PG8_WAIT_L(0); PG8_BAR; PG8_MMA(0, 0, At, B0); PG8_MMA(0, 1, At, B1); PG8_BAR; PG8_SCHED;
            PG8_LDA(At, 1, 1); PG8_STAGE(PG8_SB(1, 0), b3, voffB); PG8_STAGE(PG8_SB(1, 1), b3 + hstep, voffB); PG8_STAGE(PG8_SA(1, 0), a3, w0);
            PG8_WAIT_V(8); PG8_WAIT_L(0); PG8_BAR; PG8_MMA(1, 0, At, B0); PG8_MMA(1, 1, At, B1); PG8_BAR; PG8_SCHED;
        }
        if constexpr (ALIGN_EPI) { if (wr == 0) PG8_BAR; }
        E(acc, cur, wr, wc, fr, fq);
        if (!has_next) break;
#pragma unroll
        for (int a = 0; a < 2; ++a)
#pragma unroll
            for (int b = 0; b < 2; ++b)
#pragma unroll
                for (int m = 0; m < 4; ++m)
#pragma unroll
                    for (int n = 0; n < 2; ++n) acc[a][b][m][n] = (f32x4){0.f, 0.f, 0.f, 0.f};
        cur = nxt; cA = nA; cB = nB; ++ui;
#pragma unroll
        for (int h = 0; h < 2; ++h)
#pragma unroll
            for (int i = 0; i < 2; ++i) va[h][i] = vn[h][i];
        if constexpr (ALIGN_EPI) { if (wr == 1) PG8_BAR; }
    }
    PG8_WAIT_V(0);
    if constexpr (!ALIGN_EPI) { if (wr == 0) PG8_BAR; }
    PG8_BAR;
#undef PG8_SA
#undef PG8_SB
#undef PG8_STAGE
#undef PG8_LDA
#undef PG8_LDB
#undef PG8_MMA
#undef PG8_WAIT_V
#undef PG8_WAIT_L
#undef PG8_BAR
#undef PG8_SCHED
}
}

constexpr int NWAVES = 8, NTHR = 512;
constexpr int BATCH = 2, SEQ = 8192, D = 1024, T = BATCH * SEQ;
constexpr int NH = 8, HD = 64, AW = 512, CWD = 512, DIN = 5120, MB = 256, NBLK = SEQ / MB  , TOPK = 3;
constexpr int NE = 32, NGRP = 4, EPG = 8, DE = 512, NMOD = 6;
constexpr float NORM_EPS = 1e-6f;
constexpr float LOG2E = 1.4426950408889634f;
constexpr float QSCALE = 0.125f * LOG2E;
constexpr int CAPQ = (NBLK - 1) * MB;
constexpr int ECAP = T;
constexpr int APAD_MAX = 2 * T + NE * 255;
constexpr int MOD_KS = 16;

#ifndef MK_N_LAUNCHES
#define MK_N_LAUNCHES 1
#endif
constexpr int N_PHASES = 13;
constexpr int N_LAUNCHES = MK_N_LAUNCHES;

constexpr size_t MiB = 1u << 20;
constexpr size_t WS_CTL = 0, CTL_ZERO_BYTES = 65536;
constexpr size_t WS_MODPART = 1 * MiB;
constexpr size_t WS_MOD = 2 * MiB;
constexpr size_t WS_KMEAN = 2 * MiB + 256 * 1024;
constexpr size_t WS_TOKE = 2 * MiB + 512 * 1024;
constexpr size_t WS_TOKP = WS_TOKE + 128 * 1024;
constexpr size_t WS_ROWIDX = 3 * MiB;
constexpr size_t WS_ROWW = 5 * MiB;
constexpr size_t WS_ML = 7 * MiB;
constexpr size_t WS_LIST = 9 * MiB;
constexpr size_t WS_WIN = 25 * MiB, WS_WAO = 35 * MiB, WS_WCO = 36 * MiB, WS_WO = 37 * MiB;
constexpr size_t WS_OPART = 39 * MiB;
constexpr size_t WS_WGU = 39 * MiB, WS_WD = 103 * MiB;
constexpr size_t WS_R1 = 135 * MiB;
constexpr size_t WS_Q = 167 * MiB, WS_K = 183 * MiB, WS_V = 199 * MiB;
constexpr size_t WS_MERGED = 167 * MiB;
constexpr size_t WS_U = 215 * MiB, WS_BG = 231 * MiB;
constexpr size_t WS_CONTRIB = 167 * MiB;
constexpr size_t WS_ACT = 247 * MiB;
constexpr size_t WS_END = 287 * MiB;
static_assert(WS_CONTRIB + (size_t)APAD_MAX * 1024 * 2 <= WS_ACT && WS_ACT + (size_t)APAD_MAX * 512 * 2 <= WS_END, "ws map");
static_assert(WS_LIST + (size_t)512 * CAPQ * 4 <= WS_WIN, "ws map lists");
constexpr int CW_TMO = 0;
constexpr int CW_BAR = 4096;
constexpr int CW_QCNT = 8192;
constexpr int CW_ECNT = 9216;
constexpr int RING_BYTES = 131072;
constexpr int ROWTAB_OFF = 131072;
constexpr int MISC_OFF = 131072 + 8192;
constexpr int LDS_BYTES = 147456;

#define LDS_WAIT() asm volatile("s_waitcnt lgkmcnt(0)" ::: "memory")
#define VM_WAIT() asm volatile("s_waitcnt vmcnt(0)" ::: "memory")

#define XB_TMO      128
#define XB_XCNT(j)  (256  + 64 * (j))
#define XB_XSUB(j)  (1280 + 64 * (j))
#define XB_XGEN(j)  (2304 + 64 * (j))
#define XB_TOP      3328
#define XB_TOPGEN   3392
#define XCD_BAR_WORDS 3456
#define XB_SPIN_CAP (1u << 18)
__device__ __forceinline__ unsigned xb_ld(unsigned* p)              { return __hip_atomic_load(p, __ATOMIC_RELAXED, __HIP_MEMORY_SCOPE_AGENT); }
__device__ __forceinline__ unsigned xb_add(unsigned* p, unsigned v) { return __hip_atomic_fetch_add(p, v, __ATOMIC_RELAXED, __HIP_MEMORY_SCOPE_AGENT); }
__device__ __forceinline__ unsigned xb_xcc_id() { return (unsigned)__builtin_amdgcn_s_getreg((3 << 11) | 20) & 0xFu; }
#define XB_SPIN(cond, bar) do { unsigned _sp = 0; while (cond) { __builtin_amdgcn_s_sleep(1); \
    if ((++_sp & 255u) == 0u) { if (xb_ld(&(bar)[XB_TMO])) break; if (_sp > XB_SPIN_CAP) { atomicAdd(&(bar)[XB_TMO], 1u); break; } } } } while (0)
struct XcdBarrier { unsigned* bar; unsigned x; volatile LAS unsigned* st; };
__device__ __forceinline__ XcdBarrier xcd_barrier_post(unsigned* bar, volatile LAS unsigned* st) {
    XcdBarrier b; b.bar = bar; b.x = xb_xcc_id(); b.st = st;
    if (threadIdx.x == 0) (void)xb_add(&bar[XB_XCNT(b.x)], 1u);
    return b;
}
__device__ __forceinline__ void xcd_barrier_complete(unsigned* bar, unsigned x, unsigned& nloc, unsigned& nx) {
    const unsigned G = gridDim.x * gridDim.y * gridDim.z;
    unsigned sum, cnt, mine, sp = 0u;
    for (;;) {
        sum = 0u; cnt = 0u; mine = 0u;
#pragma unroll
        for (unsigned j = 0; j < 16; ++j) { const unsigned c = xb_ld(&bar[XB_XCNT(j)]); sum += c; cnt += (c > 0u) ? 1u : 0u; mine = (j == x) ? c : mine; }
        if (sum == G) break;
        __builtin_amdgcn_s_sleep(1);
        if ((++sp & 255u) == 0u) { if (xb_ld(&bar[XB_TMO])) break; if (sp > XB_SPIN_CAP) { atomicAdd(&bar[XB_TMO], 1u); break; } }
    }
    nloc = mine > 0u ? mine : 1u; nx = cnt > 0u ? cnt : 1u;
}
__device__ __forceinline__ void xcd_barrier(const XcdBarrier& b) {
    asm volatile("s_waitcnt vmcnt(0)" ::: "memory");
    __syncthreads();
    if (threadIdx.x == 0) {
        unsigned* bar = b.bar;
        __builtin_amdgcn_s_waitcnt(0);
        unsigned nloc = b.st[0], nx = b.st[1];
        if (nloc == 0u) { xcd_barrier_complete(bar, b.x, nloc, nx); b.st[0] = nloc; b.st[1] = nx; }
        const unsigned old = xb_add(&bar[XB_XSUB(b.x)], 1u);
        const unsigned gen = old / nloc;
        if (old + 1u == (gen + 1u) * nloc) {
            __builtin_amdgcn_fence(__ATOMIC_RELEASE, "agent");
            asm volatile("s_waitcnt vmcnt(0)" ::: "memory");
            const unsigned og = xb_add(&bar[XB_TOP], 1u);
            const unsigned tg = og / nx;
            if (og + 1u == (tg + 1u) * nx) xb_add(&bar[XB_TOPGEN], 1u);
            else XB_SPIN(xb_ld(&bar[XB_TOPGEN]) == tg, bar);
            __builtin_amdgcn_fence(__ATOMIC_ACQUIRE, "agent");
            xb_add(&bar[XB_XGEN(b.x)], 1u);
            asm volatile("s_waitcnt vmcnt(0)" ::: "memory");
        } else {
            XB_SPIN(xb_ld(&bar[XB_XGEN(b.x)]) == gen, bar);
            __builtin_amdgcn_fence(__ATOMIC_ACQUIRE, "agent");
            asm volatile("s_waitcnt vmcnt(0)" ::: "memory");
        }
    }
    __syncthreads();
}

struct Args {
    const float *x, *c, *rel_bias, *norm1_g, *norm2_g, *w_ada, *b_ada, *w_in, *b_gate, *conv_w, *w_attn_out, *w_conv_out, *w_o,
                *w_rg, *b_rg, *w_re, *b_re, *w_eg, *w_eu, *w_ed, *final_g;
    float* out; unsigned char* ws; int ph_lo, ph_hi;
};
struct Frame {
    LAS unsigned char* lds; volatile LAS unsigned* MISC; unsigned* ctl; unsigned char* ws;
    int tid, lane, wave, G, vcu;
};
__device__ __forceinline__ float wave_sum(float v) {
#pragma unroll
    for (int o = 1; o < 64; o <<= 1) v += __shfl_xor(v, o);
    return v;
}
__device__ __forceinline__ float silu_(float v) { return v * sigmoidf_(v); }

__device__ __forceinline__ void transpose_item(const float* W, int K, int N, bf16_t* WT, int k0, int n0, int drow0, LAS float* scr, int lane) {
#pragma unroll 8
    for (int i = 0; i < 32; ++i) { const int kk = 2 * i + (lane >> 5); scr[kk * 33 + (lane & 31)] = W[(size_t)(k0 + kk) * N + n0 + (lane & 31)]; }
    LDS_WAIT(); asm volatile("" ::: "memory");
    const int c = lane & 7;
#pragma unroll
    for (int j = 0; j < 4; ++j) { const int n = (lane >> 3) + 8 * j; const LAS float* s = scr + (8 * c) * 33 + n;
        u32x4 o; o.x = cvt_pk_bf16(s[0 * 33], s[1 * 33]); o.y = cvt_pk_bf16(s[2 * 33], s[3 * 33]); o.z = cvt_pk_bf16(s[4 * 33], s[5 * 33]); o.w = cvt_pk_bf16(s[6 * 33], s[7 * 33]);
        *(GAS u32x4*)(WT + (size_t)(drow0 + n) * K + k0 + 8 * c) = o; }
    LDS_WAIT(); asm volatile("" ::: "memory");
}

__device__ __forceinline__ void p0_mod_partials(Frame& F, const Args& a) {
    LAS float* cact = (LAS float*)F.lds;
    for (int i = F.tid; i < 2 * D; i += NTHR) cact[i] = silu_(a.c[i]);
    __syncthreads();
    float* modpart = (float*)(F.ws + WS_MODPART);
    const int gw = F.vcu * NWAVES + F.wave, NGW = F.G * NWAVES;
    constexpr int NCG = (NMOD * D) / 256, KSL = D / MOD_KS;
    for (int it = gw; it < NCG * MOD_KS; it += NGW) {
        const int cg = it % NCG, ks = it / NCG, col = cg * 256 + F.lane * 4;
        f32x4 a0 = {0.f, 0.f, 0.f, 0.f}, a1 = {0.f, 0.f, 0.f, 0.f};
#pragma unroll 8
        for (int k = ks * KSL; k < (ks + 1) * KSL; ++k) { const f32x4 w = *(const GAS f32x4*)(a.w_ada + (size_t)k * (NMOD * D) + col); const float c0 = cact[k], c1 = cact[D + k]; a0 += w * c0; a1 += w * c1; }
        *(GAS f32x4*)(modpart + (size_t)(ks * 2 + 0) * (NMOD * D) + col) = a0;
        *(GAS f32x4*)(modpart + (size_t)(ks * 2 + 1) * (NMOD * D) + col) = a1;
    }
}
__device__ __forceinline__ float mod_from_partials(const float* modpart, const float* b_ada, int b, int j) {
    float s = b_ada[j];
#pragma unroll
    for (int ks = 0; ks < MOD_KS; ++ks) s += modpart[(size_t)(ks * 2 + b) * (NMOD * D) + j];
    return s;
}
__device__ __forceinline__ void norm_row_to_bf16(const float* xrow, const LAS float* mul, const LAS float* add, bf16_t* orow, int lane, f32x4 (&hv)[4]) {
    const GAS f32x4* xr = (const GAS f32x4*)xrow + lane;
    f32x4 v[4]; float s = 0.f;
#pragma unroll
    for (int j = 0; j < 4; ++j) { v[j] = xr[64 * j]; s += (v[j].x * v[j].x + v[j].y * v[j].y) + (v[j].z * v[j].z + v[j].w * v[j].w); }
    const float rstd = 1.f / sqrtf(wave_sum(s) * (1.f / D) + NORM_EPS);
    GAS u32x2* o8 = (GAS u32x2*)orow + lane;
#pragma unroll
    for (int j = 0; j < 4; ++j) { const f32x4 m = *(const LAS f32x4*)(mul + 256 * j + 4 * lane), ad = *(const LAS f32x4*)(add + 256 * j + 4 * lane);
        const f32x4 h = v[j] * rstd * m + ad; hv[j] = h;
        u32x2 o; o.x = cvt_pk_bf16(h.x, h.y); o.y = cvt_pk_bf16(h.z, h.w); o8[64 * j] = o; }
}
__device__ __forceinline__ int win_dest_row(int n0) {
    if (n0 < 1536) return n0;
    if (n0 < 2048) { const int ch = n0 - 1536; return 256 * (6 + (ch >> 7)) + (ch & 127); }
    if (n0 < 2560) return 2560 + (n0 - 2048);
    if (n0 < 3072) { const int ch = n0 - 2560; return 256 * (6 + (ch >> 7)) + 128 + (ch & 127); }
    return n0;
}
__device__ __forceinline__ void p1_prologue(Frame& F, const Args& a) {
    const float* modpart = (const float*)(F.ws + WS_MODPART);
    float* mod = (float*)(F.ws + WS_MOD);
    LAS float* mul = (LAS float*)F.lds;
    LAS float* add = mul + 2 * D;
    for (int i = F.tid; i < 2 * D; i += NTHR) { const int b = i >> 10, k = i & 1023;
        const float sh = mod_from_partials(modpart, a.b_ada, b, k), sc = mod_from_partials(modpart, a.b_ada, b, D + k);
        mul[i] = a.norm1_g[k] * (1.f + sc); add[i] = sh; }
    { const int per = (2 * NMOD * D + F.G - 1) / F.G;
      for (int i = F.tid; i < per; i += NTHR) { const int idx = blockIdx.x * per + i; if (idx < 2 * NMOD * D) { const int b = idx / (NMOD * D), j = idx % (NMOD * D); mod[idx] = mod_from_partials(modpart, a.b_ada, b, j); } } }
    __syncthreads();
    const int gw = F.vcu * NWAVES + F.wave, NGW = F.G * NWAVES;
    LAS float* scr = (LAS float*)(F.lds + 16384 + F.wave * 8704);
    constexpr int I_IN = (D / 64) * (DIN / 32), I_AO = (AW / 64) * (D / 32), I_CO = I_AO, I_O = (D / 64) * (D / 32);
    for (int it = gw; it < I_IN + I_AO + I_CO + I_O; it += NGW) {
        int r = it;
        if (r < I_IN) { const int nb = r % (DIN / 32), kb = r / (DIN / 32); transpose_item(a.w_in, D, DIN, (bf16_t*)(F.ws + WS_WIN), 64 * kb, 32 * nb, win_dest_row(32 * nb), scr, F.lane); continue; } r -= I_IN;
        if (r < I_AO) { const int nb = r % (D / 32), kb = r / (D / 32); transpose_item(a.w_attn_out, AW, D, (bf16_t*)(F.ws + WS_WAO), 64 * kb, 32 * nb, 32 * nb, scr, F.lane); continue; } r -= I_AO;
        if (r < I_CO) { const int nb = r % (D / 32), kb = r / (D / 32); transpose_item(a.w_conv_out, CWD, D, (bf16_t*)(F.ws + WS_WCO), 64 * kb, 32 * nb, 32 * nb, scr, F.lane); continue; } r -= I_CO;
        { const int nb = r % (D / 32), kb = r / (D / 32); transpose_item(a.w_o, D, D, (bf16_t*)(F.ws + WS_WO), 64 * kb, 32 * nb, 32 * nb, scr, F.lane); }
    }
    bf16_t* H1 = (bf16_t*)(F.ws + WS_R1);
    for (int m = gw; m < T; m += NGW) { f32x4 hv[4]; const int b = m / SEQ; norm_row_to_bf16(a.x + (size_t)m * D, mul + b * D, add + b * D, H1 + (size_t)m * D, F.lane, hv); }
}

struct EpiInProj {
    static constexpr bool PERM = true;
    bf16_t *Q, *Kb, *V, *U, *BG, *SA, *SC; const float* b_gate;
    __device__ __forceinline__ void operator()(const f32x4 (&acc)[2][2][4][2], const pg8::Unit& u, int wr, int wc, int fr, int fq) const {
        const int pn = u.pn, row0 = u.pm * 256 + wr * 64 + fr, colw = wc * 32 + 8 * fq;
        if (pn >= 6 && pn < 10) {
            const int ch0 = (pn - 6) * 128 + colw;
#pragma unroll
            for (int ai = 0; ai < 2; ++ai)
#pragma unroll
                for (int m = 0; m < 4; ++m) { const f32x4 v0 = acc[ai][0][m][0] * acc[ai][1][m][0], v1 = acc[ai][0][m][1] * acc[ai][1][m][1];
                    u32x4 w; w.x = cvt_pk_bf16(v0[0], v0[1]); w.y = cvt_pk_bf16(v0[2], v0[3]); w.z = cvt_pk_bf16(v1[0], v1[1]); w.w = cvt_pk_bf16(v1[2], v1[3]);
                    *(GAS u32x4*)(U + (size_t)(row0 + ai * 128 + m * 16) * 512 + ch0) = w; }
        } else if (pn >= 12) {
            bf16_t* dst = pn < 16 ? SA : SC; const int ct = (pn & 3) * 256, bt = (pn - 12) * 256;
#pragma unroll
            for (int bj = 0; bj < 2; ++bj) { const f32x4 b0 = *(const GAS f32x4*)(b_gate + bt + bj * 128 + colw), b1 = *(const GAS f32x4*)(b_gate + bt + bj * 128 + colw + 4);
#pragma unroll
                for (int ai = 0; ai < 2; ++ai)
#pragma unroll
                    for (int m = 0; m < 4; ++m) { const f32x4 v0 = acc[ai][bj][m][0] + b0, v1 = acc[ai][bj][m][1] + b1;
                        u32x4 w; w.x = cvt_pk_bf16(sigmoidf_(v0[0]), sigmoidf_(v0[1])); w.y = cvt_pk_bf16(sigmoidf_(v0[2]), sigmoidf_(v0[3]));
                        w.z = cvt_pk_bf16(sigmoidf_(v1[0]), sigmoidf_(v1[1])); w.w = cvt_pk_bf16(sigmoidf_(v1[2]), sigmoidf_(v1[3]));
                        *(GAS u32x4*)(dst + (size_t)(row0 + ai * 128 + m * 16) * 1024 + ct + bj * 128 + colw) = w; } }
        } else {
            bf16_t* dst = pn < 2 ? Q : pn < 4 ? Kb : pn < 6 ? V : BG; const float sc = pn < 2 ? QSCALE : 1.f; const int ct = (pn & 1) * 256;
#pragma unroll
            for (int ai = 0; ai < 2; ++ai)
#pragma unroll
                for (int m = 0; m < 4; ++m)
#pragma unroll
                    for (int bj = 0; bj < 2; ++bj) { const f32x4 v0 = acc[ai][bj][m][0] * sc, v1 = acc[ai][bj][m][1] * sc;
                        u32x4 w; w.x = cvt_pk_bf16(v0[0], v0[1]); w.y = cvt_pk_bf16(v0[2], v0[3]); w.z = cvt_pk_bf16(v1[0], v1[1]); w.w = cvt_pk_bf16(v1[2], v1[3]);
                        *(GAS u32x4*)(dst + (size_t)(row0 + ai * 128 + m * 16) * 512 + ct + bj * 128 + colw) = w; }
        }
    }
};

__device__ __forceinline__ void p3_kmean(Frame& F) {
    const bf16_t* Kb = (const bf16_t*)(F.ws + WS_K); float* kmean = (float*)(F.ws + WS_KMEAN);
    LAS float* red = (LAS float*)F.lds;
    for (int it = F.vcu; it < BATCH * NBLK * 4; it += F.G) {
        const int bn = it >> 2, cq = it & 3, cc = F.tid & 15, rg = F.tid >> 4;
        float s[8] = {0.f, 0.f, 0.f, 0.f, 0.f, 0.f, 0.f, 0.f};
#pragma unroll
        for (int r = 0; r < 8; ++r) { const u32x4 v = *(const GAS u32x4*)(Kb + (size_t)(bn * 256 + rg * 8 + r) * 512 + cq * 128 + cc * 8);
            s[0] += bf_lo(v.x); s[1] += bf_hi(v.x); s[2] += bf_lo(v.y); s[3] += bf_hi(v.y); s[4] += bf_lo(v.z); s[5] += bf_hi(v.z); s[6] += bf_lo(v.w); s[7] += bf_hi(v.w); }
#pragma unroll
        for (int j = 0; j < 8; ++j) red[rg * 128 + cc * 8 + j] = s[j];
        __syncthreads();
        if (F.tid < 128) { float t = 0.f;
#pragma unroll
            for (int g = 0; g < 32; ++g) t += red[g * 128 + F.tid];
            kmean[(size_t)bn * 512 + cq * 128 + F.tid] = t * (1.f / 256.f); }
        __syncthreads();
    }
}

__device__ __forceinline__ void p4_topk(Frame& F) {
    const bf16_t* Q = (const bf16_t*)(F.ws + WS_Q); const float* kmean = (const float*)(F.ws + WS_KMEAN);
    unsigned* qcnt = F.ctl + CW_QCNT; unsigned* list = (unsigned*)(F.ws + WS_LIST);
    LAS float* km = (LAS float*)F.lds;
    LAS unsigned* lcnt = (LAS unsigned*)(F.lds + 16384);
    LAS unsigned* lbase = lcnt + 64;
    for (int it = F.vcu; it < BATCH * (NBLK - 1) * 4; it += F.G) {
        const int hp = it & 3, qb = 1 + (it >> 2) % (NBLK - 1), b = (it >> 2) / (NBLK - 1);
        for (int i = F.tid; i < 2 * qb * 64; i += NTHR) { const int hl = i / (qb * 64), r = i % (qb * 64), n = r >> 6, d = r & 63;
            km[(hl * 32 + n) * 64 + d] = kmean[(size_t)(b * NBLK + n) * 512 + (2 * hp + hl) * 64 + d]; }
        if (F.tid < 128) lcnt[F.tid] = 0u;
        __syncthreads();
        const int ql = F.tid & 255, hl = F.tid >> 8, h = 2 * hp + hl, t = qb * 256 + ql;
        float q[64];
        { const GAS u32x4* qp = (const GAS u32x4*)(Q + (size_t)(b * SEQ + t) * 512 + h * 64);
#pragma unroll
          for (int c = 0; c < 8; ++c) { const u32x4 v = qp[c]; q[8 * c] = bf_lo(v.x); q[8 * c + 1] = bf_hi(v.x); q[8 * c + 2] = bf_lo(v.y); q[8 * c + 3] = bf_hi(v.y); q[8 * c + 4] = bf_lo(v.z); q[8 * c + 5] = bf_hi(v.z); q[8 * c + 6] = bf_lo(v.w); q[8 * c + 7] = bf_hi(v.w); } }
        float v0 = -3e38f, v1 = -3e38f, v2 = -3e38f; int i0 = 0, i1 = 0, i2 = 0;
        for (int n = 0; n < qb; ++n) {
            const LAS f32x4* kp = (const LAS f32x4*)(km + (hl * 32 + n) * 64); float g = 0.f;
#pragma unroll
            for (int c = 0; c < 16; ++c) { const f32x4 kv = kp[c]; g += q[4 * c] * kv.x + q[4 * c + 1] * kv.y + q[4 * c + 2] * kv.z + q[4 * c + 3] * kv.w; }
            if (g > v0) { v2 = v1; i2 = i1; v1 = v0; i1 = i0; v0 = g; i0 = n; }
            else if (g > v1) { v2 = v1; i2 = i1; v1 = g; i1 = n; }
            else if (g > v2) { v2 = g; i2 = n; }
        }
        const int nsel = qb < TOPK ? qb : TOPK;
        unsigned p0 = 0, p1 = 0, p2 = 0;
        p0 = __hip_atomic_fetch_add(&lcnt[hl * 32 + i0], 1u, __ATOMIC_RELAXED, __HIP_MEMORY_SCOPE_WORKGROUP);
        if (nsel > 1) p1 = __hip_atomic_fetch_add(&lcnt[hl * 32 + i1], 1u, __ATOMIC_RELAXED, __HIP_MEMORY_SCOPE_WORKGROUP);
        if (nsel > 2) p2 = __hip_atomic_fetch_add(&lcnt[hl * 32 + i2], 1u, __ATOMIC_RELAXED, __HIP_MEMORY_SCOPE_WORKGROUP);
        __syncthreads();
        if (F.tid < 64) { const int hl2 = F.tid >> 5, n = F.tid & 31; const unsigned c = lcnt[F.tid];
            lbase[F.tid] = c ? atomicAdd(&qcnt[(b * NH + 2 * hp + hl2) * NBLK + n], c) : 0u; }
        __syncthreads();
        const size_t lb = (size_t)((b * NH + h) * NBLK);
        list[(lb + i0) * CAPQ + lbase[hl * 32 + i0] + p0] = (unsigned)t | (0u << 13);
        if (nsel > 1) list[(lb + i1) * CAPQ + lbase[hl * 32 + i1] + p1] = (unsigned)t | (1u << 13);
        if (nsel > 2) list[(lb + i2) * CAPQ + lbase[hl * 32 + i2] + p2] = (unsigned)t | (2u << 13);
        __syncthreads();
    }
}

__device__ __forceinline__ int crow(int r, int hi) { return (r & 3) + 8 * (r >> 2) + 4 * hi; }
__device__ __forceinline__ float swap_max(float m) { auto rr = __builtin_amdgcn_permlane32_swap(__float_as_uint(m), __float_as_uint(m), false, false); return fmaxf(__uint_as_float(rr[0]), __uint_as_float(rr[1])); }
__device__ __forceinline__ float swap_sum(float m) { auto rr = __builtin_amdgcn_permlane32_swap(__float_as_uint(m), __float_as_uint(m), false, false); return __uint_as_float(rr[0]) + __uint_as_float(rr[1]); }
__device__ __forceinline__ s16x4 vtr(const LAS unsigned char* p) { return __builtin_bit_cast(s16x4, __builtin_amdgcn_ds_read_tr16_b64_v4i16((LAS s16x4*)p)); }
constexpr int AT_K = 0, AT_V = 32768, AT_OST = 65536, AT_LW = 98304, AT_META = 100352, AT_TAB = 102400, AT_PFX = 106496;
__device__ __forceinline__ void p5_attention(Frame& F, const Args& a) {
    const bf16_t* Q = (const bf16_t*)(F.ws + WS_Q); const bf16_t* Kb = (const bf16_t*)(F.ws + WS_K); const bf16_t* V = (const bf16_t*)(F.ws + WS_V);
    bf16_t* OP = (bf16_t*)(F.ws + WS_OPART); float* ML = (float*)(F.ws + WS_ML);
    const unsigned* qcnt = F.ctl + CW_QCNT; const unsigned* list = (const unsigned*)(F.ws + WS_LIST);
    LAS unsigned char* lds = F.lds; const int tid = F.tid, lane = F.lane, w = F.wave, r32 = lane & 31, hi = lane >> 5;
    LAS float* tab = (LAS float*)(lds + AT_TAB); LAS int* pfx = (LAS int*)(lds + AT_PFX);
    for (int i = tid; i < NH * 128; i += NTHR) { const int h = i >> 7, d = i & 127; int bk;
        if (d < 16) bk = d; else { bk = 16 + (d >= 19) + (d >= 21) + (d >= 24) + (d >= 27) + (d >= 31) + (d >= 35) + (d >= 40) + (d >= 46) + (d >= 52) + (d >= 59) + (d >= 67) + (d >= 77) + (d >= 87) + (d >= 99) + (d >= 113); }
        tab[i] = a.rel_bias[bk * NH + h] * LOG2E; }
    { const int c = (int)qcnt[tid]; pfx[tid + 1] = (c + 255) / 256 + 1; if (tid == 0) pfx[0] = 0; }
    __syncthreads();
    for (int o = 1; o < 512; o <<= 1) { int v = pfx[tid + 1]; if (tid >= o) v += pfx[tid + 1 - o]; __syncthreads(); pfx[tid + 1] = v; __syncthreads(); }
    const int nitems = pfx[512];
    LAS float* lw = (LAS float*)(lds + AT_LW) + w * 64; LAS unsigned* meta = (LAS unsigned*)(lds + AT_META) + w * 32;
    LAS bf16_t* stg = (LAS bf16_t*)(lds + AT_OST) + w * 2048;
    for (int it = F.vcu; it < nitems; it += F.G) {
        int lo = 0, hh = 511; while (lo < hh) { const int mid = (lo + hh + 1) >> 1; if (pfx[mid] <= it) lo = mid; else hh = mid - 1; }
        const int idx = lo, j = it - pfx[idx], nch = pfx[idx + 1] - pfx[idx] - 1; const bool own = (j == nch);
        const int n = idx & 31, h = (idx >> 5) & 7, b = idx >> 8; const int cnt = (int)qcnt[idx];
        const int nvalid = own ? 256 : (cnt - j * 256 < 256 ? cnt - j * 256 : 256);
        { const size_t g0 = ((size_t)(b * SEQ + n * 256)) * 512 + h * 64;
#pragma unroll
          for (int i = 0; i < 4; ++i) { const int ci = tid + i * 512, row = ci >> 3, c = ci & 7;
              const u32x4 kv = *(const GAS u32x4*)(Kb + g0 + (size_t)row * 512 + c * 8); const u32x4 vv = *(const GAS u32x4*)(V + g0 + (size_t)row * 512 + c * 8);
              *(LAS u32x4*)(lds + AT_K + row * 128 + ((c ^ ((row >> 1) & 7)) << 4)) = kv;
              *(LAS u32x4*)(lds + AT_V + row * 128 + ((c ^ (((row >> 1) & 1) << 2)) << 4)) = vv; } }
        const int rowi = 32 * w + r32; const bool valid = rowi < nvalid;
        unsigned ent = own ? ((unsigned)(n * 256 + rowi) | (3u << 13)) : list[(size_t)idx * CAPQ + j * 256 + (valid ? rowi : 0)];
        const int tq = (int)(ent & 8191u), slot = (int)(ent >> 13) & 3;
        if (hi == 0) meta[r32] = (unsigned)tq | ((unsigned)slot << 13) | (valid ? 0x8000u : 0u);
        __syncthreads();
        if (32 * w < nvalid) {
            bf16x8 qf[4];
            { const GAS bf16x8* qp = (const GAS bf16x8*)(Q + (size_t)(b * SEQ + tq) * 512 + h * 64 + 8 * hi);
#pragma unroll
              for (int s = 0; s < 4; ++s) qf[s] = qp[2 * s]; }
            f32x16 p[8];
#pragma unroll
            for (int i = 0; i < 8; ++i) { const int row = 32 * i + r32; const LAS unsigned char* kr = lds + AT_K + row * 128; const int sw = (row >> 1) & 7;
                f32x16 accp = {0.f, 0.f, 0.f, 0.f, 0.f, 0.f, 0.f, 0.f, 0.f, 0.f, 0.f, 0.f, 0.f, 0.f, 0.f, 0.f};
#pragma unroll
                for (int s = 0; s < 4; ++s) { const bf16x8 kf = *(const LAS bf16x8*)(kr + (((2 * s + hi) ^ sw) << 4)); accp = __builtin_amdgcn_mfma_f32_32x32x16_bf16(kf, qf[s], accp, 0, 0, 0); }
                p[i] = accp; }
            const int kbase = n * 256; const LAS float* tb = tab + h * 128;
            const bool far = !own && __all((!valid) || (tq - kbase - 255 >= 127));
            if (!far) {
#pragma unroll
                for (int i = 0; i < 8; ++i)
#pragma unroll
                    for (int r = 0; r < 16; ++r) { const int dist = tq - (kbase + 32 * i + crow(r, hi)); const int di = dist < 0 ? 0 : (dist > 127 ? 127 : dist);
                        const float sv = p[i][r] + tb[di]; p[i][r] = (own && dist < 0) ? -INFINITY : sv; }
            }
            float mx = -INFINITY;
#pragma unroll
            for (int i = 0; i < 8; ++i)
#pragma unroll
                for (int r = 0; r < 16; ++r) mx = fmaxf(mx, p[i][r]);
            mx = swap_max(mx);
            float ls = 0.f;
#pragma unroll
            for (int i = 0; i < 8; ++i)
#pragma unroll
                for (int r = 0; r < 16; ++r) { const float e = __builtin_amdgcn_exp2f(p[i][r] - mx); p[i][r] = e; ls += e; }
            ls = swap_sum(ls);
            f32x16 o0 = {0.f, 0.f, 0.f, 0.f, 0.f, 0.f, 0.f, 0.f, 0.f, 0.f, 0.f, 0.f, 0.f, 0.f, 0.f, 0.f}, o1 = o0;
            { const int L = lane & 15, qq = L >> 2, pp = L & 3, sq = (qq >> 1) & 1, cc = 2 * ((lane >> 4) & 1) + (pp >> 1);
              const LAS unsigned char* vb0 = lds + AT_V + (4 * hi + qq) * 128 + ((4 * sq + cc) << 4) + (pp & 1) * 8;
              const LAS unsigned char* vb1 = lds + AT_V + (4 * hi + qq) * 128 + ((4 * (1 ^ sq) + cc) << 4) + (pp & 1) * 8;
#pragma unroll
              for (int i = 0; i < 8; ++i)
#pragma unroll
                  for (int s2 = 0; s2 < 2; ++s2) {
                      u32x4 pw; pw.x = cvt_pk_bf16(p[i][8 * s2 + 0], p[i][8 * s2 + 1]); pw.y = cvt_pk_bf16(p[i][8 * s2 + 2], p[i][8 * s2 + 3]); pw.z = cvt_pk_bf16(p[i][8 * s2 + 4], p[i][8 * s2 + 5]); pw.w = cvt_pk_bf16(p[i][8 * s2 + 6], p[i][8 * s2 + 7]);
                      const bf16x8 pa = __builtin_bit_cast(bf16x8, pw); const int off = (32 * i + 16 * s2) * 128;
                      const s16x4 a0 = vtr(vb0 + off), a1 = vtr(vb0 + off + 1024), c0 = vtr(vb1 + off), c1 = vtr(vb1 + off + 1024);
                      const bf16x8 vf0 = {a0[0], a0[1], a0[2], a0[3], a1[0], a1[1], a1[2], a1[3]}, vf1 = {c0[0], c0[1], c0[2], c0[3], c1[0], c1[1], c1[2], c1[3]};
                      o0 = __builtin_amdgcn_mfma_f32_32x32x16_bf16(pa, vf0, o0, 0, 0, 0); o1 = __builtin_amdgcn_mfma_f32_32x32x16_bf16(pa, vf1, o1, 0, 0, 0); } }
            if (hi == 0) { lw[r32] = ls; if (valid) ML[((size_t)(b * SEQ + tq) * NH + h) * 4 + slot] = mx + __builtin_amdgcn_logf(ls) + (far ? tb[127] : 0.f); }
            LDS_WAIT();
#pragma unroll
            for (int r = 0; r < 16; ++r) { const int orow = crow(r, hi); const float rl = __builtin_amdgcn_rcpf(lw[orow]);
                stg[orow * 64 + r32] = (bf16_t)(cvt_pk_bf16(o0[r] * rl, 0.f) & 0xffffu); stg[orow * 64 + 32 + r32] = (bf16_t)(cvt_pk_bf16(o1[r] * rl, 0.f) & 0xffffu); }
            LDS_WAIT();
#pragma unroll
            for (int i = 0; i < 4; ++i) { const int row = i * 8 + (lane >> 3), ch = lane & 7; const unsigned mt = meta[row];
                if (mt & 0x8000u) { const u32x4 v = *(const LAS u32x4*)(stg + row * 64 + ch * 8); const int tt = (int)(mt & 8191u), sl = (int)(mt >> 13) & 3;
                    *(GAS u32x4*)(OP + (((size_t)(b * SEQ + tt) * NH + h) * 4 + sl) * 64 + ch * 8) = v; } }
        }
        __syncthreads();
    }
}

__device__ __forceinline__ void p6_combine_conv(Frame& F, const Args& a) {
    const bf16_t* OP = (const bf16_t*)(F.ws + WS_OPART); const float* ML = (const float*)(F.ws + WS_ML);
    const bf16_t* U = (const bf16_t*)(F.ws + WS_U); const bf16_t* BG = (const bf16_t*)(F.ws + WS_BG);
    bf16_t* ATT = (bf16_t*)(F.ws + WS_R1); bf16_t* CV = ATT + (size_t)T * 512;
    const int gw = F.vcu * NWAVES + F.wave, NGW = F.G * NWAVES, lane = F.lane;
    float cw[3][8];
#pragma unroll
    for (int j = 0; j < 3; ++j)
#pragma unroll
        for (int c = 0; c < 8; ++c) cw[j][c] = a.conv_w[j * CWD + lane * 8 + c];
    for (int tg = gw; tg < T; tg += NGW) {
        const int tb = tg & (SEQ - 1), qb = tb >> 8, nsel = qb < TOPK ? qb : TOPK, hd = lane >> 3, ch = lane & 7;
        const size_t pb = ((size_t)tg * NH + hd) * 4;
        const f32x4 l4 = *(const GAS f32x4*)(ML + pb);
        float ls[4] = {l4.x, l4.y, l4.z, l4.w}; float M = ls[3];
#pragma unroll
        for (int s = 0; s < 3; ++s) if (s < nsel) M = fmaxf(M, ls[s]);
        float acc[8] = {0.f, 0.f, 0.f, 0.f, 0.f, 0.f, 0.f, 0.f}; float W = 0.f;
#pragma unroll
        for (int s = 0; s < 4; ++s) if (s == 3 || s < nsel) { const float wg = __builtin_amdgcn_exp2f(ls[s] - M); W += wg;
            const u32x4 v = *(const GAS u32x4*)(OP + (pb + s) * 64 + ch * 8);
            acc[0] += wg * bf_lo(v.x); acc[1] += wg * bf_hi(v.x); acc[2] += wg * bf_lo(v.y); acc[3] += wg * bf_hi(v.y); acc[4] += wg * bf_lo(v.z); acc[5] += wg * bf_hi(v.z); acc[6] += wg * bf_lo(v.w); acc[7] += wg * bf_hi(v.w); }
        const float rW = 1.f / W;
        { u32x4 o; o.x = cvt_pk_bf16(acc[0] * rW, acc[1] * rW); o.y = cvt_pk_bf16(acc[2] * rW, acc[3] * rW); o.z = cvt_pk_bf16(acc[4] * rW, acc[5] * rW); o.w = cvt_pk_bf16(acc[6] * rW, acc[7] * rW);
          *(GAS u32x4*)(ATT + (size_t)tg * 512 + lane * 8) = o; }
        float y[8];
        { const u32x4 v = *(const GAS u32x4*)(U + (size_t)tg * 512 + lane * 8);
          y[0] = cw[2][0] * bf_lo(v.x); y[1] = cw[2][1] * bf_hi(v.x); y[2] = cw[2][2] * bf_lo(v.y); y[3] = cw[2][3] * bf_hi(v.y); y[4] = cw[2][4] * bf_lo(v.z); y[5] = cw[2][5] * bf_hi(v.z); y[6] = cw[2][6] * bf_lo(v.w); y[7] = cw[2][7] * bf_hi(v.w); }
        if (tb >= 1) { const u32x4 v = *(const GAS u32x4*)(U + (size_t)(tg - 1) * 512 + lane * 8);
          y[0] += cw[1][0] * bf_lo(v.x); y[1] += cw[1][1] * bf_hi(v.x); y[2] += cw[1][2] * bf_lo(v.y); y[3] += cw[1][3] * bf_hi(v.y); y[4] += cw[1][4] * bf_lo(v.z); y[5] += cw[1][5] * bf_hi(v.z); y[6] += cw[1][6] * bf_lo(v.w); y[7] += cw[1][7] * bf_hi(v.w); }
        if (tb >= 2) { const u32x4 v = *(const GAS u32x4*)(U + (size_t)(tg - 2) * 512 + lane * 8);
          y[0] += cw[0][0] * bf_lo(v.x); y[1] += cw[0][1] * bf_hi(v.x); y[2] += cw[0][2] * bf_lo(v.y); y[3] += cw[0][3] * bf_hi(v.y); y[4] += cw[0][4] * bf_lo(v.z); y[5] += cw[0][5] * bf_hi(v.z); y[6] += cw[0][6] * bf_lo(v.w); y[7] += cw[0][7] * bf_hi(v.w); }
        { const u32x4 g = *(const GAS u32x4*)(BG + (size_t)tg * 512 + lane * 8);
          u32x4 o; o.x = cvt_pk_bf16(y[0] * bf_lo(g.x), y[1] * bf_hi(g.x)); o.y = cvt_pk_bf16(y[2] * bf_lo(g.y), y[3] * bf_hi(g.y)); o.z = cvt_pk_bf16(y[4] * bf_lo(g.z), y[5] * bf_hi(g.z)); o.w = cvt_pk_bf16(y[6] * bf_lo(g.w), y[7] * bf_hi(g.w));
          *(GAS u32x4*)(CV + (size_t)tg * 512 + lane * 8) = o; }
    }
}

template <bool ADD> struct EpiGate {
    static constexpr bool PERM = true;
    bf16_t* MG; const bf16_t* S;
    __device__ __forceinline__ void operator()(const f32x4 (&acc)[2][2][4][2], const pg8::Unit& u, int wr, int wc, int fr, int fq) const {
        const int row0 = u.pm * 256 + wr * 64 + fr, col0 = u.pn * 256 + wc * 32 + 8 * fq;
#pragma unroll
        for (int ai = 0; ai < 2; ++ai)
#pragma unroll
            for (int m = 0; m < 4; ++m)
#pragma unroll
                for (int bj = 0; bj < 2; ++bj) { const size_t off = (size_t)(row0 + ai * 128 + m * 16) * 1024 + col0 + bj * 128;
                    const u32x4 g = *(const GAS u32x4*)(S + off); const f32x4 a0 = acc[ai][bj][m][0], a1 = acc[ai][bj][m][1];
                    float v[8] = {a0[0] * bf_lo(g.x), a0[1] * bf_hi(g.x), a0[2] * bf_lo(g.y), a0[3] * bf_hi(g.y), a1[0] * bf_lo(g.z), a1[1] * bf_hi(g.z), a1[2] * bf_lo(g.w), a1[3] * bf_hi(g.w)};
                    if constexpr (ADD) { const u32x4 pz = *(const GAS u32x4*)(MG + off);
                        v[0] += bf_lo(pz.x); v[1] += bf_hi(pz.x); v[2] += bf_lo(pz.y); v[3] += bf_hi(pz.y); v[4] += bf_lo(pz.z); v[5] += bf_hi(pz.z); v[6] += bf_lo(pz.w); v[7] += bf_hi(pz.w); }
                    u32x4 w; w.x = cvt_pk_bf16(v[0], v[1]); w.y = cvt_pk_bf16(v[2], v[3]); w.z = cvt_pk_bf16(v[4], v[5]); w.w = cvt_pk_bf16(v[6], v[7]);
                    *(GAS u32x4*)(MG + off) = w; }
    }
};
struct EpiResid {
    static constexpr bool PERM = false;
    const float* x; float* X1; const float* g1;
    __device__ __forceinline__ void operator()(const f32x4 (&acc)[2][2][4][2], const pg8::Unit& u, int wr, int wc, int fr, int fq) const {
        const int row0 = u.pm * 256 + wr * 64 + fr, col0 = u.pn * 256 + wc * 32 + 4 * fq; const int b = (u.pm * 256) / SEQ;
        f32x4 gv[2][2];
#pragma unroll
        for (int bj = 0; bj < 2; ++bj)
#pragma unroll
            for (int n = 0; n < 2; ++n) gv[bj][n] = *(const GAS f32x4*)(g1 + (size_t)b * (NMOD * D) + col0 + bj * 128 + n * 16);
#pragma unroll
        for (int ai = 0; ai < 2; ++ai)
#pragma unroll
            for (int m = 0; m < 4; ++m) { const size_t ro = (size_t)(row0 + ai * 128 + m * 16) * D + col0;
#pragma unroll
                for (int bj = 0; bj < 2; ++bj)
#pragma unroll
                    for (int n = 0; n < 2; ++n) { const f32x4 xv = *(const GAS f32x4*)(x + ro + bj * 128 + n * 16); *(GAS f32x4*)(X1 + ro + bj * 128 + n * 16) = xv + gv[bj][n] * acc[ai][bj][m][n]; } }
    }
};

__device__ __forceinline__ void p9_norm_route(Frame& F, const Args& a) {
    const int gw = F.vcu * NWAVES + F.wave, NGW = F.G * NWAVES, lane = F.lane, tid = F.tid;
    {
        LAS float* scr = (LAS float*)(F.lds + F.wave * 8704);
        constexpr int I_G = (D / 64) * (DE / 32), I_D = (DE / 64) * (D / 32), PER_E = 2 * I_G + I_D;
        for (int it = gw; it < NE * PER_E; it += NGW) {
            const int e = it / PER_E; int r = it % PER_E;
            bf16_t* wgu = (bf16_t*)(F.ws + WS_WGU) + (size_t)e * 1024 * 1024; bf16_t* wd = (bf16_t*)(F.ws + WS_WD) + (size_t)e * 1024 * 512;
            if (r < 2 * I_G) { const int up = r >= I_G; if (up) r -= I_G; const int nb = r % (DE / 32), kb = r / (DE / 32), n0 = 32 * nb;
                transpose_item((up ? a.w_eu : a.w_eg) + (size_t)e * D * DE, D, DE, wgu, 64 * kb, n0, 256 * (n0 >> 7) + (n0 & 127) + (up ? 128 : 0), scr, lane); }
            else { r -= 2 * I_G; const int nb = r % (D / 32), kb = r / (D / 32); transpose_item(a.w_ed + (size_t)e * DE * D, DE, D, wd, 64 * kb, 32 * nb, 32 * nb, scr, lane); }
        }
    }
    __syncthreads();
    const float* mod = (const float*)(F.ws + WS_MOD);
    LAS bf16_t* wr_ = (LAS bf16_t*)F.lds;
    LAS float* mul = (LAS float*)(F.lds + 73728);
    LAS float* add = mul + 2 * D;
    LAS float* rb = add + 2 * D;
    LAS int* asg_e = (LAS int*)(rb + 64);
    LAS unsigned* asg_p = (LAS unsigned*)(asg_e + 128);
    LAS float* asg_w = (LAS float*)(asg_p + 128);
    LAS unsigned* lcnt = (LAS unsigned*)(asg_w + 128);
    LAS unsigned* lbase = lcnt + 32;
    for (int i = tid; i < D * 32; i += NTHR) { const int k = i >> 5, c = i & 31; wr_[(4 + c) * D + k] = (bf16_t)(cvt_pk_bf16(a.w_re[i], 0.f) & 0xffffu); }
    for (int i = tid; i < D * 4; i += NTHR) { const int k = i >> 2, c = i & 3; wr_[c * D + k] = (bf16_t)(cvt_pk_bf16(a.w_rg[i], 0.f) & 0xffffu); }
    for (int i = tid; i < 2 * D; i += NTHR) { const int b = i >> 10, k = i & 1023; mul[i] = a.norm2_g[k] * (1.f + mod[b * (NMOD * D) + 4 * D + k]); add[i] = mod[b * (NMOD * D) + 3 * D + k]; }
    if (tid < 4) rb[tid] = a.b_rg[tid]; else if (tid < 36) rb[tid] = a.b_re[tid - 4];
    __syncthreads();
    const float* X1 = a.out; bf16_t* H2 = (bf16_t*)(F.ws + WS_R1);
    int* tok_e = (int*)(F.ws + WS_TOKE); int* tok_p = (int*)(F.ws + WS_TOKP); int* rowidx = (int*)(F.ws + WS_ROWIDX); float* roww = (float*)(F.ws + WS_ROWW);
    unsigned* ecnt = F.ctl + CW_ECNT;
    for (int rbk = F.vcu; rbk < T / 64; rbk += F.G) {
        if (tid < 32) lcnt[tid] = 0u;
        __syncthreads();
#pragma unroll 1
        for (int i = 0; i < 8; ++i) {
            const int m = rbk * 64 + F.wave * 8 + i, b = m / SEQ; f32x4 hv[4];
            norm_row_to_bf16(X1 + (size_t)m * D, mul + b * D, add + b * D, H2 + (size_t)m * D, lane, hv);
            float lg[36];
#pragma unroll
            for (int c = 0; c < 36; ++c) { float s = 0.f;
#pragma unroll
                for (int j = 0; j < 4; ++j) { const u32x2 wv = *(const LAS u32x2*)(wr_ + c * D + 256 * j + 4 * lane); s += hv[j].x * bf_lo(wv.x) + hv[j].y * bf_hi(wv.x) + hv[j].z * bf_lo(wv.y) + hv[j].w * bf_hi(wv.y); }
                lg[c] = wave_sum(s) + rb[c]; }
            int gs = 0; float gm = lg[0];
#pragma unroll
            for (int g = 1; g < 4; ++g) if (lg[g] > gm) { gm = lg[g]; gs = g; }
            float gden = 0.f;
#pragma unroll
            for (int g = 0; g < 4; ++g) gden += __expf(lg[g] - gm);
            const float g_w = 1.f / gden;
            float el[8];
#pragma unroll
            for (int j = 0; j < 8; ++j) el[j] = gs == 0 ? lg[4 + j] : gs == 1 ? lg[12 + j] : gs == 2 ? lg[20 + j] : lg[28 + j];
            int i0 = 0; float m0 = el[0];
#pragma unroll
            for (int j = 1; j < 8; ++j) if (el[j] > m0) { m0 = el[j]; i0 = j; }
            int i1 = -1; float m1 = -3e38f;
#pragma unroll
            for (int j = 0; j < 8; ++j) if (j != i0 && el[j] > m1) { m1 = el[j]; i1 = j; }
            const float e1 = __expf(m1 - m0), w0 = g_w / (1.f + e1), w1 = g_w * e1 / (1.f + e1);
            if (lane < 2) { asg_e[(F.wave * 8 + i) * 2 + lane] = lane == 0 ? gs * 8 + i0 : gs * 8 + i1; asg_w[(F.wave * 8 + i) * 2 + lane] = lane == 0 ? w0 : w1; }
        }
        __syncthreads();
        if (tid < 128) asg_p[tid] = __hip_atomic_fetch_add(&lcnt[asg_e[tid]], 1u, __ATOMIC_RELAXED, __HIP_MEMORY_SCOPE_WORKGROUP);
        __syncthreads();
        if (tid < 32) { const unsigned c = lcnt[tid]; lbase[tid] = c ? atomicAdd(&ecnt[tid], c) : 0u; }
        __syncthreads();
        if (tid < 128) { const int m = rbk * 64 + (tid >> 1), e = asg_e[tid]; const int pos = (int)(lbase[e] + asg_p[tid]);
            tok_e[m * 2 + (tid & 1)] = e; tok_p[m * 2 + (tid & 1)] = pos; rowidx[(size_t)e * ECAP + pos] = m; roww[(size_t)e * ECAP + pos] = asg_w[tid]; }
        __syncthreads();
    }
}

struct MoeOrder {
    const LAS int* tpre;
    const LAS int* cnts;
    const LAS int* rowtab;
    const char* A; const char* B; size_t a_tile_bytes, b_exp_bytes, b_tile_bytes; int G, c, nunits;
    __device__ bool next(int i, pg8::Unit& u) const {
        const long L = (long)i * G + c; if (L >= nunits) return false;
        int wgid = (int)L; { const int q = nunits / 8, r = nunits % 8, xcd = wgid % 8, off = wgid / 8; wgid = (xcd < r ? xcd * (q + 1) : r * (q + 1) + (xcd - r) * q) + off; }
        const int ti = wgid >> 2; u.pn = wgid & 3; u.pm = ti;
        int e = 0;
#pragma unroll 1
        for (int s = 16; s >= 1; s >>= 1) if (tpre[e + s] <= ti) e += s;
        u.e = e; const int r0 = (ti - tpre[e]) * 256; u.nvalid = cnts[e] - r0 < 256 ? cnts[e] - r0 : 256;
        u.A = A + (size_t)ti * a_tile_bytes; u.B = B + (size_t)e * b_exp_bytes + (size_t)u.pn * b_tile_bytes; return true;
    }
    __device__ __forceinline__ unsigned arow(int i, int r) const { return (unsigned)rowtab[(i & 7) * 256 + r]; }
};
__device__ __forceinline__ int moe_setup(Frame& F, LAS int* tpre, LAS int* cnts) {
    const unsigned* ecnt = F.ctl + CW_ECNT;
    if (F.tid == 0) { int acc = 0; for (int e = 0; e < NE; ++e) { const int c = (int)ecnt[e]; cnts[e] = c; tpre[e] = acc; acc += (c + 255) >> 8; } tpre[NE] = acc; }
    __syncthreads();
    return tpre[NE];
}
struct EpiSwiglu {
    static constexpr bool PERM = true;
    bf16_t* ACT;
    __device__ __forceinline__ void operator()(const f32x4 (&acc)[2][2][4][2], const pg8::Unit& u, int wr, int wc, int fr, int fq) const {
        const int row0 = u.pm * 256 + wr * 64 + fr, ch0 = u.pn * 128 + wc * 32 + 8 * fq;
#pragma unroll
        for (int ai = 0; ai < 2; ++ai)
#pragma unroll
            for (int m = 0; m < 4; ++m) { const f32x4 g0 = acc[ai][0][m][0], g1 = acc[ai][0][m][1], u0 = acc[ai][1][m][0], u1 = acc[ai][1][m][1];
                u32x4 w; w.x = cvt_pk_bf16(silu_(g0[0]) * u0[0], silu_(g0[1]) * u0[1]); w.y = cvt_pk_bf16(silu_(g0[2]) * u0[2], silu_(g0[3]) * u0[3]);
                w.z = cvt_pk_bf16(silu_(g1[0]) * u1[0], silu_(g1[1]) * u1[1]); w.w = cvt_pk_bf16(silu_(g1[2]) * u1[2], silu_(g1[3]) * u1[3]);
                *(GAS u32x4*)(ACT + (size_t)(row0 + ai * 128 + m * 16) * 512 + ch0) = w; }
    }
};
struct EpiDown {
    static constexpr bool PERM = true;
    bf16_t* CT; const float* roww; const LAS int* tpre;
    __device__ __forceinline__ void operator()(const f32x4 (&acc)[2][2][4][2], const pg8::Unit& u, int wr, int wc, int fr, int fq) const {
        const int lr0 = wr * 64 + fr, col0 = u.pn * 256 + wc * 32 + 8 * fq; const int pos0 = (u.pm - tpre[u.e]) * 256;
#pragma unroll
        for (int ai = 0; ai < 2; ++ai)
#pragma unroll
            for (int m = 0; m < 4; ++m) { const int lr = lr0 + ai * 128 + m * 16; const float wt = lr < u.nvalid ? roww[(size_t)u.e * ECAP + pos0 + lr] : 0.f;
#pragma unroll
                for (int bj = 0; bj < 2; ++bj) { const f32x4 v0 = acc[ai][bj][m][0] * wt, v1 = acc[ai][bj][m][1] * wt;
                    u32x4 w; w.x = cvt_pk_bf16(v0[0], v0[1]); w.y = cvt_pk_bf16(v0[2], v0[3]); w.z = cvt_pk_bf16(v1[0], v1[1]); w.w = cvt_pk_bf16(v1[2], v1[3]);
                    *(GAS u32x4*)(CT + (size_t)(u.pm * 256 + lr) * 1024 + col0 + bj * 128) = w; } }
    }
};

__device__ __forceinline__ void p12_final(Frame& F, const Args& a) {
    LAS int* tpre = (LAS int*)(F.lds + 0); LAS int* cnts = tpre + 64;
    moe_setup(F, tpre, cnts);
    LAS float* g2 = (LAS float*)(F.lds + 1024);
    LAS float* fg = g2 + 2 * D;
    const float* mod = (const float*)(F.ws + WS_MOD);
    for (int i = F.tid; i < 2 * D; i += NTHR) g2[i] = mod[(i >> 10) * (NMOD * D) + 5 * D + (i & 1023)];
    for (int i = F.tid; i < D; i += NTHR) fg[i] = a.final_g[i];
    __syncthreads();
    const int* tok_e = (const int*)(F.ws + WS_TOKE); const int* tok_p = (const int*)(F.ws + WS_TOKP); const bf16_t* CT = (const bf16_t*)(F.ws + WS_CONTRIB);
    const int gw = F.vcu * NWAVES + F.wave, NGW = F.G * NWAVES, lane = F.lane;
    for (int m = gw; m < T; m += NGW) {
        const int b = m / SEQ; const int e0 = tok_e[m * 2], e1 = tok_e[m * 2 + 1];
        const size_t r0 = (size_t)(tpre[e0] * 256 + tok_p[m * 2]), r1 = (size_t)(tpre[e1] * 256 + tok_p[m * 2 + 1]);
        const GAS f32x4* xr = (const GAS f32x4*)(a.out + (size_t)m * D) + lane;
        const GAS u32x2* c0 = (const GAS u32x2*)(CT + r0 * 1024) + lane; const GAS u32x2* c1 = (const GAS u32x2*)(CT + r1 * 1024) + lane;
        f32x4 v[4]; float s = 0.f;
#pragma unroll
        for (int j = 0; j < 4; ++j) { const f32x4 xv = xr[64 * j]; const u32x2 p = c0[64 * j], q = c1[64 * j]; const f32x4 g = *(const LAS f32x4*)(g2 + b * D + 256 * j + 4 * lane);
            f32x4 y; y.x = bf_lo(p.x) + bf_lo(q.x); y.y = bf_hi(p.x) + bf_hi(q.x); y.z = bf_lo(p.y) + bf_lo(q.y); y.w = bf_hi(p.y) + bf_hi(q.y);
            v[j] = xv + g * y; s += (v[j].x * v[j].x + v[j].y * v[j].y) + (v[j].z * v[j].z + v[j].w * v[j].w); }
        const float rstd = 1.f / sqrtf(wave_sum(s) * (1.f / D) + NORM_EPS);
        GAS f32x4* orow = (GAS f32x4*)(a.out + (size_t)m * D) + lane;
#pragma unroll
        for (int j = 0; j < 4; ++j) orow[64 * j] = v[j] * rstd * *(const LAS f32x4*)(fg + 256 * j + 4 * lane);
    }
}

__global__ void __launch_bounds__(NTHR, 2) mk_fwd(Args args) {
    extern __shared__ __attribute__((aligned(16))) unsigned char lds_raw[];
    Frame F;
    F.lds = (LAS unsigned char*)lds_raw; F.MISC = (volatile LAS unsigned*)(F.lds + MISC_OFF);
    F.tid = threadIdx.x; F.lane = F.tid & 63; F.wave = __builtin_amdgcn_readfirstlane(F.tid >> 6);
    F.G = gridDim.x; { const int bx = blockIdx.x; F.vcu = (F.G % 8 == 0) ? (bx % 8) * (F.G / 8) + bx / 8 : bx; }
    F.ws = args.ws; F.ctl = (unsigned*)(args.ws + WS_CTL);
    if (F.tid < 64) F.MISC[F.tid] = 0u;
    __syncthreads();
    XcdBarrier bar; bar.bar = F.ctl + CW_BAR; bar.x = 0; bar.st = nullptr;
    if (N_LAUNCHES == 1) bar = xcd_barrier_post(F.ctl + CW_BAR, F.MISC + 8);
    const int lo = args.ph_lo, hi = args.ph_hi;
#define IN(k) (lo <= (k) && (k) < hi)
#define SEAM(k) do { if (IN(k) && IN((k) + 1)) xcd_barrier(bar); } while (0)
    unsigned char* ws = args.ws;

    if (IN(0)) { p0_mod_partials(F, args); } SEAM(0);
    if (IN(1)) { p1_prologue(F, args); } SEAM(1);
    if (IN(2)) {
        pg8::StaticOrder S; S.init(ws + WS_R1, ws + WS_WIN, T, DIN, D, F.G, (int)blockIdx.x);
        EpiInProj E{(bf16_t*)(ws + WS_Q), (bf16_t*)(ws + WS_K), (bf16_t*)(ws + WS_V), (bf16_t*)(ws + WS_U), (bf16_t*)(ws + WS_BG), (bf16_t*)args.out, (bf16_t*)args.out + (size_t)T * D, args.b_gate};
        pg8::gemm_phase<EpiInProj, pg8::StaticOrder, true, false>(F.lds, D, S, E);
    } SEAM(2);
    if (IN(3)) { p3_kmean(F); } SEAM(3);
    if (IN(4)) { p4_topk(F); } SEAM(4);
    if (IN(5)) { p5_attention(F, args); } SEAM(5);
    if (IN(6)) { p6_combine_conv(F, args); } SEAM(6);
    if (IN(7)) {
        { pg8::StaticOrder S; S.init(ws + WS_R1, ws + WS_WAO, T, D, AW, F.G, (int)blockIdx.x);
          EpiGate<false> E{(bf16_t*)(ws + WS_MERGED), (const bf16_t*)args.out};
          pg8::gemm_phase<EpiGate<false>, pg8::StaticOrder, false, false>(F.lds, AW, S, E); }
        VM_WAIT(); __syncthreads();
        { pg8::StaticOrder S; S.init(ws + WS_R1 + (size_t)T * 512 * 2, ws + WS_WCO, T, D, CWD, F.G, (int)blockIdx.x);
          EpiGate<true> E{(bf16_t*)(ws + WS_MERGED), (const bf16_t*)args.out + (size_t)T * D};
          pg8::gemm_phase<EpiGate<true>, pg8::StaticOrder, false, false>(F.lds, CWD, S, E); }
    } SEAM(7);
    if (IN(8)) {
        pg8::StaticOrder S; S.init(ws + WS_MERGED, ws + WS_WO, T, D, D, F.G, (int)blockIdx.x);
        EpiResid E{args.x, args.out, (const float*)(ws + WS_MOD) + 2 * D};
        pg8::gemm_phase<EpiResid, pg8::StaticOrder, false, false>(F.lds, D, S, E);
    } SEAM(8);
    if (IN(9)) { p9_norm_route(F, args); } SEAM(9);
    if (IN(10)) {
        LAS int* tpre = (LAS int*)(F.lds + MISC_OFF + 256); LAS int* cnts = tpre + 64; LAS int* rowtab = (LAS int*)(F.lds + ROWTAB_OFF);
        const int ntiles = moe_setup(F, tpre, cnts);
        MoeOrder S{tpre, cnts, rowtab, (const char*)(ws + WS_R1), (const char*)(ws + WS_WGU), 0, (size_t)1024 * 1024 * 2, (size_t)256 * 1024 * 2, F.G, (int)blockIdx.x, ntiles * 4};
        { pg8::Unit u; const int* rowidx = (const int*)(ws + WS_ROWIDX);
          for (int i = 0; i < 8 && S.next(i, u); ++i) { if (F.tid < 256) { const int r0 = (u.pm - tpre[u.e]) * 256; rowtab[i * 256 + F.tid] = F.tid < u.nvalid ? rowidx[(size_t)u.e * ECAP + r0 + F.tid] : rowidx[(size_t)u.e * ECAP + r0]; } } }
        __syncthreads();
        EpiSwiglu E{(bf16_t*)(ws + WS_ACT)};
        pg8::gemm_phase<EpiSwiglu, MoeOrder, true, true>(F.lds, D, S, E);
    } SEAM(10);
    if (IN(11)) {
        LAS int* tpre = (LAS int*)(F.lds + MISC_OFF + 256); LAS int* cnts = tpre + 64;
        const int ntiles = moe_setup(F, tpre, cnts);
        MoeOrder S{tpre, cnts, nullptr, (const char*)(ws + WS_ACT), (const char*)(ws + WS_WD), (size_t)256 * 512 * 2, (size_t)1024 * 512 * 2, (size_t)256 * 512 * 2, F.G, (int)blockIdx.x, ntiles * 4};
        EpiDown E{(bf16_t*)(ws + WS_CONTRIB), (const float*)(ws + WS_ROWW), tpre};
        pg8::gemm_phase<EpiDown, MoeOrder, true, false>(F.lds, DE, S, E);
    } SEAM(11);
    if (IN(12)) { p12_final(F, args); }
#undef IN
#undef SEAM
}

extern "C" void kernel_launch(void* const* d_in, const int* in_sizes, int n_in, void* d_out, int out_size, void* d_ws, size_t ws_size, hipStream_t stream) {
    static int grid = 0;
    if (grid == 0) {
        if (n_in != 21 || in_sizes[0] != T * D || out_size != T * D || ws_size < WS_END) { fprintf(stderr, "kernel_launch: unexpected shapes (n_in %d, in0 %d, out %d, ws %zu < %zu)\n", n_in, n_in > 0 ? in_sizes[0] : -1, out_size, ws_size, (size_t)WS_END); grid = -1; return; }
        int dev = 0, cus = 0, per_cu = 0;
        if (hipGetDevice(&dev) != hipSuccess || hipDeviceGetAttribute(&cus, hipDeviceAttributeMultiprocessorCount, dev) != hipSuccess) { grid = -1; return; }
        if (hipFuncSetAttribute((const void*)mk_fwd, hipFuncAttributeMaxDynamicSharedMemorySize, LDS_BYTES) != hipSuccess) { fprintf(stderr, "kernel_launch: hipFuncSetAttribute failed\n"); grid = -1; return; }
        if (hipOccupancyMaxActiveBlocksPerMultiprocessor(&per_cu, (const void*)mk_fwd, NTHR, LDS_BYTES) != hipSuccess || per_cu < 1) fprintf(stderr, "kernel_launch: occupancy query reports %d\n", per_cu);
        (void)hipGetLastError();
        grid = cus;
    }
    if (grid < 0) return;
    if (hipMemsetAsync((char*)d_ws + WS_CTL, 0, CTL_ZERO_BYTES, stream) != hipSuccess) return;
    Args a{};
    const float** ap = (const float**)&a;
    for (int i = 0; i < 21; ++i) ap[i] = (const float*)d_in[i];
    a.out = (float*)d_out; a.ws = (unsigned char*)d_ws;
    for (int li = 0; li < N_LAUNCHES; ++li) {
        a.ph_lo = (N_LAUNCHES == 1) ? 0 : li; a.ph_hi = (N_LAUNCHES == 1) ? N_PHASES : li + 1;
        hipLaunchKernelGGL(mk_fwd, dim3(grid), dim3(NTHR), LDS_BYTES, stream, a);
        if (hipPeekAtLastError() != hipSuccess) { fprintf(stderr, "kernel_launch: launch %d failed\n", li); break; }
    }
}
```

```cpp
#include <hip/hip_runtime.h>
#include <cstdio>
#include <cstdint>
#define PROBE_PH (-1)

#define LAS __attribute__((address_space(3)))
#define GAS __attribute__((address_space(1)))
typedef unsigned short bf16_t;
typedef short bf16x8 __attribute__((ext_vector_type(8)));
typedef short s16x4 __attribute__((ext_vector_type(4)));
typedef float f32x4 __attribute__((ext_vector_type(4)));
typedef float f32x16 __attribute__((ext_vector_type(16)));
typedef float f32x2 __attribute__((ext_vector_type(2)));
typedef unsigned u32x4 __attribute__((ext_vector_type(4)));
typedef unsigned u32x2 __attribute__((ext_vector_type(2)));
typedef __bf16 bf16x2_t __attribute__((ext_vector_type(2)));

__device__ __forceinline__ unsigned cvt_pk_bf16(float lo, float hi) { f32x2 v = {lo, hi}; bf16x2_t b = __builtin_convertvector(v, bf16x2_t); return __builtin_bit_cast(unsigned, b); }
__device__ __forceinline__ float bf_lo(unsigned u) { return __builtin_bit_cast(float, u << 16); }
__device__ __forceinline__ float bf_hi(unsigned u) { return __builtin_bit_cast(float, u & 0xffff0000u); }
__device__ __forceinline__ float sigmoidf_(float x) { return __builtin_amdgcn_rcpf(1.f + __expf(-x)); }

namespace pg8 {
constexpr int BM = 256, BK = 64, HALF = 128, HTB = HALF * BK * 2, STAGE_BYTES = 8 * HTB, NXCD = 8, WGM = 8;
__host__ __device__ __forceinline__ int lds_byte(int r, int c) { const int st = (r >> 4) * 2 + (c >> 5), rr = r & 15, cc = c & 31, ob = rr * 64 + cc * 2; return st * 1024 + (ob ^ (((ob >> 9) & 1) << 5)); }
__host__ __device__ __forceinline__ void stage_rc(int b, int& R, int& C) { const int st = b / 1024, sb = b % 1024, swz = sb ^ (((sb >> 9) & 1) << 5); R = (st >> 1) * 16 + swz / 64; C = (st & 1) * 32 + (swz % 64) / 2; }
__host__ __device__ __forceinline__ int perm32(int rho) { const int n = rho >> 4, i = rho & 15; return 8 * (i >> 2) + 4 * n + (i & 3); }

struct Unit { const char* A; const char* B; int pm, pn, e, nvalid; };

struct StaticOrder {
    const char* A; const char* Bt; int K; int nM, nN, nwg, G, c;
    __device__ void init(const void* A_, const void* Bt_, int M, int N, int K_, int G_, int c_) { A = (const char*)A_; Bt = (const char*)Bt_; K = K_; nM = M / BM; nN = N / BM; nwg = nM * nN; G = G_; c = c_; }
    __device__ bool next(int i, Unit& u) const {
        const long L = (long)i * G + c; if (L >= nwg) return false;
        int wgid = (int)L; { const int q = nwg / NXCD, r = nwg % NXCD, xcd = wgid % NXCD, off = wgid / NXCD; wgid = (xcd < r ? xcd * (q + 1) : r * (q + 1) + (xcd - r) * q) + off; }
        const int nig = WGM * nN, gid = wgid / nig, fm = gid * WGM, gsz = (nM - fm) < WGM ? (nM - fm) : WGM;
        u.pm = fm + ((wgid % nig) % gsz); u.pn = (wgid % nig) / gsz; u.e = 0; u.nvalid = 256;
        u.A = A + (size_t)u.pm * 256 * K * 2; u.B = Bt + (size_t)u.pn * 256 * K * 2; return true;
    }
    __device__ __forceinline__ unsigned arow(int, int) const { return 0u; }
};

template <class Epi, class Sched, bool ALIGN_EPI, bool GATHER>
__device__ __forceinline__ void gemm_phase(LAS unsigned char* lds, const int K, const Sched& S, const Epi& E) {
    const int tid = threadIdx.x, wid = __builtin_amdgcn_readfirstlane(tid >> 6), lane = tid & 63, wr = wid >> 2, wc = wid & 3, fr = lane & 15, fq = lane >> 4;
    const int nt = K / BK;
    unsigned voffB[2]; int RA[2], CA[2];
#pragma unroll
    for (int i = 0; i < 2; ++i) { int R, C; stage_rc(tid * 16 + i * 8192, R, C); const int Rb = Epi::PERM ? ((R & ~31) + perm32(R & 31)) : R;
        RA[i] = R; CA[i] = C; voffB[i] = (unsigned)(Rb * K + C) * 2u; }
    const size_t kstep = (size_t)(BK * 2);
    const size_t hstep = (size_t)HALF * K * 2;
    const unsigned ldsw = (unsigned)wid * 1024u;
    const int aoff = lds_byte(wr * 64 + fr, fq * 8), boff = lds_byte(wc * 32 + fr, fq * 8);
#define PG8_SA(b, h) (((b) * 2 + (h)) * HTB)
#define PG8_SB(b, h) ((4 + (b) * 2 + (h)) * HTB)
#define PG8_STAGE(bufoff, gbase, voff) do { _Pragma("unroll") for (int _i = 0; _i < 2; ++_i) \
        __builtin_amdgcn_global_load_lds((const unsigned*)((const char*)(gbase) + (voff)[_i]), (LAS unsigned*)(lds + (bufoff) + ldsw + _i * 8192), 16, 0, 0); } while (0)
#define PG8_LDA(dst, b, h) do { _Pragma("unroll") for (int m = 0; m < 4; ++m) _Pragma("unroll") for (int k = 0; k < 2; ++k) dst[m][k] = *(const LAS bf16x8*)(lds + PG8_SA(b, h) + aoff + m * 2048 + k * 1024); } while (0)
#define PG8_LDB(dst, b, h) do { _Pragma("unroll") for (int n = 0; n < 2; ++n) _Pragma("unroll") for (int k = 0; k < 2; ++k) dst[n][k] = *(const LAS bf16x8*)(lds + PG8_SB(b, h) + boff + n * 2048 + k * 1024); } while (0)
#define PG8_MMA(ai, bj, At, Bt) do { __builtin_amdgcn_s_setprio(1); _Pragma("unroll") for (int m = 0; m < 4; ++m) _Pragma("unroll") for (int n = 0; n < 2; ++n) _Pragma("unroll") for (int k = 0; k < 2; ++k) \
        acc[ai][bj][m][n] = __builtin_amdgcn_mfma_f32_16x16x32_bf16(Bt[n][k], At[m][k], acc[ai][bj][m][n], 0, 0, 0); __builtin_amdgcn_s_setprio(0); } while (0)
#define PG8_WAIT_V(n) asm volatile("s_waitcnt vmcnt(" #n ")" ::: "memory")
#define PG8_WAIT_L(n) asm volatile("s_waitcnt lgkmcnt(" #n ")" ::: "memory")
#define PG8_BAR __builtin_amdgcn_s_barrier()
#define PG8_SCHED __builtin_amdgcn_sched_barrier(0)
    Unit cur, nxt; int ui = 0;
    if (!S.next(0, cur)) return;
    f32x4 acc[2][2][4][2];
#pragma unroll
    for (int a = 0; a < 2; ++a)
#pragma unroll
        for (int b = 0; b < 2; ++b)
#pragma unroll
            for (int m = 0; m < 4; ++m)
#pragma unroll
                for (int n = 0; n < 2; ++n) acc[a][b][m][n] = (f32x4){0.f, 0.f, 0.f, 0.f};
    bf16x8 At[4][2], B0[2][2], B1[2][2];
    unsigned va[2][2], vn[2][2];
#pragma unroll
    for (int h = 0; h < 2; ++h)
#pragma unroll
        for (int i = 0; i < 2; ++i) {
            if constexpr (GATHER) va[h][i] = S.arow(0, h * HALF + RA[i]) * (unsigned)(K * 2) + (unsigned)(CA[i] * 2);
            else va[h][i] = (unsigned)((h * HALF + RA[i]) * K + CA[i]) * 2u;
            vn[h][i] = va[h][i]; }
    const char* cA = cur.A; const char* cB = cur.B;
    PG8_STAGE(PG8_SB(0, 0), cB, voffB); PG8_STAGE(PG8_SB(0, 1), cB + hstep, voffB); PG8_STAGE(PG8_SA(0, 0), cA, va[0]); PG8_STAGE(PG8_SA(0, 1), cA, va[1]);
    if (wr == 1) PG8_BAR;
    PG8_WAIT_V(2); PG8_BAR;
    PG8_STAGE(PG8_SB(1, 0), cB + kstep, voffB); PG8_STAGE(PG8_SA(1, 0), cA + kstep, va[0]); PG8_STAGE(PG8_SB(1, 1), cB + hstep + kstep, voffB);
    PG8_WAIT_V(6); PG8_BAR;
    for (;;) {
        const bool has_next = S.next(ui + 1, nxt);
        const char* nA = has_next ? nxt.A : cA; const char* nB = has_next ? nxt.B : cB;
        if constexpr (GATHER) { if (has_next) {
#pragma unroll
            for (int h = 0; h < 2; ++h)
#pragma unroll
                for (int i = 0; i < 2; ++i) vn[h][i] = S.arow(ui + 1, h * HALF + RA[i]) * (unsigned)(K * 2) + (unsigned)(CA[i] * 2); } }
        for (int t = 0; t < nt; t += 2) {
            const bool last = (t == nt - 2);
            const char* a1 = cA + (size_t)(t + 1) * kstep;
            const char* a2 = last ? nA : cA + (size_t)(t + 2) * kstep; const char* b2 = last ? nB : cB + (size_t)(t + 2) * kstep;
            const char* a3 = a2 + kstep; const char* b3 = b2 + kstep;
            unsigned w0[2], w1[2];
            if constexpr (GATHER) { w0[0] = last ? vn[0][0] : va[0][0]; w0[1] = last ? vn[0][1] : va[0][1]; w1[0] = last ? vn[1][0] : va[1][0]; w1[1] = last ? vn[1][1] : va[1][1]; }
            else { w0[0] = va[0][0]; w0[1] = va[0][1]; w1[0] = va[1][0]; w1[1] = va[1][1]; }
            PG8_LDB(B0, 0, 0); PG8_LDB(B1, 0, 1); PG8_SCHED; PG8_LDA(At, 0, 0); PG8_STAGE(PG8_SA(1, 1), a1, va[1]);
            PG8_WAIT_V(8); PG8_WAIT_L(0); PG8_BAR; PG8_MMA(0, 0, At, B0); PG8_MMA(0, 1, At, B1); PG8_BAR; PG8_SCHED;
            PG8_LDA(At, 0, 1); PG8_STAGE(PG8_SB(0, 0), b2, voffB); PG8_STAGE(PG8_SB(0, 1), b2 + hstep, voffB); PG8_STAGE(PG8_SA(0, 0), a2, w0);
            PG8_WAIT_V(8); PG8_WAIT_L(0); PG8_BAR; PG8_MMA(1, 0, At, B0); PG8_MMA(1, 1, At, B1); PG8_BAR; PG8_SCHED;
            PG8_LDB(B0, 1, 0); PG8_LDB(B1, 1, 1); PG8_SCHED; PG8_LDA(At, 1, 0); PG8_STAGE(PG8_SA(0, 1), a2, w1);
            PG8_WAIT_V(8); PG8_WAIT_L(0); PG8_BAR; PG8_MMA(0, 0, At, B0); PG8_MMA(0, 1, At, B1); PG8_BAR; PG8_SCHED;
            PG8_LDA(At, 1, 1); PG8_STAGE(PG8_SB(1, 0), b3, voffB); PG8_STAGE(PG8_SB(1, 1), b3 + hstep, voffB); PG8_STAGE(PG8_SA(1, 0), a3, w0);
            PG8_WAIT_V(8); PG8_WAIT_L(0); PG8_BAR; PG8_MMA(1, 0, At, B0); PG8_MMA(1, 1, At, B1); PG8_BAR; PG8_SCHED;
        }
        if constexpr (ALIGN_EPI) { if (wr == 0) PG8_BAR; }
        E(acc, cur, wr, wc, fr, fq);
        if (!has_next) break;
#pragma unroll
        for (int a = 0; a < 2; ++a)
#pragma unroll
            for (int b = 0; b < 2; ++b)
#pragma unroll
                for (int m = 0; m < 4; ++m)
#pragma unroll
                    for (int n = 0; n < 2; ++n) acc[a][b][m][n] = (f32x4){0.f, 0.f, 0.f, 0.f};
        cur = nxt; cA = nA; cB = nB; ++ui;
#pragma unroll
        for (int h = 0; h < 2; ++h)
#pragma unroll
            for (int i = 0; i < 2; ++i) va[h][i] = vn[h][i];
        if constexpr (ALIGN_EPI) { if (wr == 1) PG8_BAR; }
    }
    PG8_WAIT_V(0);
    if constexpr (!ALIGN_EPI) { if (wr == 0) PG8_BAR; }
    PG8_BAR;
#undef PG8_SA
#undef PG8_SB
#undef PG8_STAGE
#undef PG8_LDA
#undef PG8_LDB
#undef PG8_MMA
#undef PG8_WAIT_V
#undef PG8_WAIT_L
#undef PG8_BAR
#undef PG8_SCHED
}
}

constexpr int NWAVES = 8, NTHR = 512;
constexpr int BATCH = 2, SEQ = 8192, D = 1024, T = BATCH * SEQ;
constexpr int NH = 8, HD = 64, AW = 512, CWD = 512, DIN = 5120, MB = 256, NBLK = SEQ / MB  , TOPK = 3;
constexpr int NE = 32, NGRP = 4, EPG = 8, DE = 512, NMOD = 6;
constexpr float NORM_EPS = 1e-6f;
constexpr float LOG2E = 1.4426950408889634f;
constexpr float QSCALE = 0.125f * LOG2E;
constexpr int CAPQ = (NBLK - 1) * MB;
constexpr int ECAP = T;
constexpr int APAD_MAX = 2 * T + NE * 255;
constexpr int MOD_KS = 16;

#ifndef MK_N_LAUNCHES
#define MK_N_LAUNCHES 1
#endif
constexpr int N_PHASES = 14;
constexpr int N_LAUNCHES = MK_N_LAUNCHES;

constexpr size_t MiB = 1u << 20;
constexpr size_t WS_CTL = 0, CTL_ZERO_BYTES = 65536;
constexpr size_t WS_MODPART = 1 * MiB;
constexpr size_t WS_MODV = 2 * MiB;
constexpr size_t WS_WRT = 2 * MiB + 768 * 1024;
constexpr size_t WS_KMEAN = 2 * MiB + 256 * 1024;
constexpr size_t WS_TOKE = 2 * MiB + 512 * 1024;
constexpr size_t WS_TOKP = WS_TOKE + 128 * 1024;
constexpr size_t WS_ROWIDX = 3 * MiB;
constexpr size_t WS_ROWW = 5 * MiB;
constexpr size_t WS_ML = 7 * MiB;
constexpr size_t WS_LIST = 9 * MiB;
constexpr size_t WS_WIN = 25 * MiB, WS_WAO = 35 * MiB, WS_WCO = 36 * MiB, WS_WO = 37 * MiB;
constexpr size_t WS_OPART = 39 * MiB;
constexpr size_t WS_WGU = 39 * MiB, WS_WD = 103 * MiB;
constexpr size_t WS_R1 = 135 * MiB;
constexpr size_t WS_Q = 167 * MiB, WS_K = 183 * MiB, WS_V = 199 * MiB;
constexpr size_t WS_MERGED = 167 * MiB;
constexpr size_t WS_U = 215 * MiB, WS_BG = 231 * MiB;
constexpr size_t WS_CONTRIB = 167 * MiB;
constexpr size_t WS_ACT = 247 * MiB;
constexpr size_t WS_END = 287 * MiB;
static_assert(WS_CONTRIB + (size_t)APAD_MAX * 1024 * 2 <= WS_ACT && WS_ACT + (size_t)APAD_MAX * 512 * 2 <= WS_END, "ws map");
static_assert(WS_LIST + (size_t)512 * CAPQ * 4 <= WS_WIN, "ws map lists");
constexpr int CW_TMO = 0;
constexpr int CW_BAR = 4096;
constexpr int CW_QCNT = 8192;
constexpr int CW_ECNT = 9216;
constexpr int RING_BYTES = 131072;
constexpr int ROWTAB_OFF = 131072;
constexpr int LDS_BYTES = 163840;
constexpr int MISC_OFF = LDS_BYTES - 1024;

#define LDS_WAIT() asm volatile("s_waitcnt lgkmcnt(0)" ::: "memory")
#define VM_WAIT() asm volatile("s_waitcnt vmcnt(0)" ::: "memory")

#define XB_TMO      128
#define XB_XCNT(j)  (256  + 64 * (j))
#define XB_XSUB(j)  (1280 + 64 * (j))
#define XB_XGEN(j)  (2304 + 64 * (j))
#define XB_TOP      3328
#define XB_TOPGEN   3392
#define XCD_BAR_WORDS 3456
#define XB_SPIN_CAP (1u << 18)
__device__ __forceinline__ unsigned xb_ld(unsigned* p)              { return __hip_atomic_load(p, __ATOMIC_RELAXED, __HIP_MEMORY_SCOPE_AGENT); }
__device__ __forceinline__ unsigned xb_add(unsigned* p, unsigned v) { return __hip_atomic_fetch_add(p, v, __ATOMIC_RELAXED, __HIP_MEMORY_SCOPE_AGENT); }
__device__ __forceinline__ unsigned xb_xcc_id() { return (unsigned)__builtin_amdgcn_s_getreg((3 << 11) | 20) & 0xFu; }
#define XB_SPIN(cond, bar) do { unsigned _sp = 0; while (cond) { __builtin_amdgcn_s_sleep(1); \
    if ((++_sp & 255u) == 0u) { if (xb_ld(&(bar)[XB_TMO])) break; if (_sp > XB_SPIN_CAP) { atomicAdd(&(bar)[XB_TMO], 1u); break; } } } } while (0)
struct XcdBarrier { unsigned* bar; unsigned x; volatile LAS unsigned* st; };
__device__ __forceinline__ XcdBarrier xcd_barrier_post(unsigned* bar, volatile LAS unsigned* st) {
    XcdBarrier b; b.bar = bar; b.x = xb_xcc_id(); b.st = st;
    if (threadIdx.x == 0) (void)xb_add(&bar[XB_XCNT(b.x)], 1u);
    return b;
}
__device__ __forceinline__ void xcd_barrier_complete(unsigned* bar, unsigned x, unsigned& nloc, unsigned& nx) {
    const unsigned G = gridDim.x * gridDim.y * gridDim.z;
    unsigned sum, cnt, mine, sp = 0u;
    for (;;) {
        sum = 0u; cnt = 0u; mine = 0u;
#pragma unroll
        for (unsigned j = 0; j < 16; ++j) { const unsigned c = xb_ld(&bar[XB_XCNT(j)]); sum += c; cnt += (c > 0u) ? 1u : 0u; mine = (j == x) ? c : mine; }
        if (sum == G) break;
        __builtin_amdgcn_s_sleep(1);
        if ((++sp & 255u) == 0u) { if (xb_ld(&bar[XB_TMO])) break; if (sp > XB_SPIN_CAP) { atomicAdd(&bar[XB_TMO], 1u); break; } }
    }
    nloc = mine > 0u ? mine : 1u; nx = cnt > 0u ? cnt : 1u;
}
__device__ __forceinline__ void xcd_barrier(const XcdBarrier& b) {
    asm volatile("s_waitcnt vmcnt(0)" ::: "memory");
    __syncthreads();
    if (threadIdx.x == 0) {
        unsigned* bar = b.bar;
        __builtin_amdgcn_s_waitcnt(0);
        unsigned nloc = b.st[0], nx = b.st[1];
        if (nloc == 0u) { xcd_barrier_complete(bar, b.x, nloc, nx); b.st[0] = nloc; b.st[1] = nx; }
        const unsigned old = xb_add(&bar[XB_XSUB(b.x)], 1u);
        const unsigned gen = old / nloc;
        if (old + 1u == (gen + 1u) * nloc) {
            __builtin_amdgcn_fence(__ATOMIC_RELEASE, "agent");
            asm volatile("s_waitcnt vmcnt(0)" ::: "memory");
            const unsigned og = xb_add(&bar[XB_TOP], 1u);
            const unsigned tg = og / nx;
            if (og + 1u == (tg + 1u) * nx) xb_add(&bar[XB_TOPGEN], 1u);
            else XB_SPIN(xb_ld(&bar[XB_TOPGEN]) == tg, bar);
            __builtin_amdgcn_fence(__ATOMIC_ACQUIRE, "agent");
            xb_add(&bar[XB_XGEN(b.x)], 1u);
            asm volatile("s_waitcnt vmcnt(0)" ::: "memory");
        } else {
            XB_SPIN(xb_ld(&bar[XB_XGEN(b.x)]) == gen, bar);
            __builtin_amdgcn_fence(__ATOMIC_ACQUIRE, "agent");
            asm volatile("s_waitcnt vmcnt(0)" ::: "memory");
        }
    }
    __syncthreads();
}

struct Args {
    const float *x, *c, *rel_bias, *norm1_g, *norm2_g, *w_ada, *b_ada, *w_in, *b_gate, *conv_w, *w_attn_out, *w_conv_out, *w_o,
                *w_rg, *b_rg, *w_re, *b_re, *w_eg, *w_eu, *w_ed, *final_g;
    float* out; unsigned char* ws; int ph_lo, ph_hi;
};
struct Frame {
    LAS unsigned char* lds; volatile LAS unsigned* MISC; unsigned* ctl; unsigned char* ws;
    int tid, lane, wave, G, vcu;
};
__device__ __forceinline__ float wave_sum(float v) {
#pragma unroll
    for (int o = 1; o < 64; o <<= 1) v += __shfl_xor(v, o);
    return v;
}
__device__ __forceinline__ float silu_(float v) { return v * sigmoidf_(v); }

__device__ __forceinline__ void transpose_item(const float* W, int K, int N, bf16_t* WT, int k0, int n0, int drow0, LAS float* scr, int lane) {
#pragma unroll 8
    for (int i = 0; i < 32; ++i) { const int kk = 2 * i + (lane >> 5); scr[kk * 33 + (lane & 31)] = W[(size_t)(k0 + kk) * N + n0 + (lane & 31)]; }
    LDS_WAIT(); asm volatile("" ::: "memory");
    const int c = lane & 7;
#pragma unroll
    for (int j = 0; j < 4; ++j) { const int n = (lane >> 3) + 8 * j; const LAS float* s = scr + (8 * c) * 33 + n;
        u32x4 o; o.x = cvt_pk_bf16(s[0 * 33], s[1 * 33]); o.y = cvt_pk_bf16(s[2 * 33], s[3 * 33]); o.z = cvt_pk_bf16(s[4 * 33], s[5 * 33]); o.w = cvt_pk_bf16(s[6 * 33], s[7 * 33]);
        *(GAS u32x4*)(WT + (size_t)(drow0 + n) * K + k0 + 8 * c) = o; }
    LDS_WAIT(); asm volatile("" ::: "memory");
}

__device__ __forceinline__ int win_dest_row(int n0) {
    if (n0 < 1536) return n0;
    if (n0 < 2048) { const int ch = n0 - 1536; return 256 * (6 + (ch >> 7)) + (ch & 127); }
    if (n0 < 2560) return 2560 + (n0 - 2048);
    if (n0 < 3072) { const int ch = n0 - 2560; return 256 * (6 + (ch >> 7)) + 128 + (ch & 127); }
    return n0;
}
__device__ __forceinline__ void p0_prologue(Frame& F, const Args& a) {
    LAS float* cact = (LAS float*)F.lds;
    for (int i = F.tid; i < 2 * D; i += NTHR) cact[i] = silu_(a.c[i]);
    __syncthreads();
    float* modpart = (float*)(F.ws + WS_MODPART);
    const int gw = F.vcu * NWAVES + F.wave, NGW = F.G * NWAVES, lane = F.lane;
    constexpr int NCG = (NMOD * D) / 64, KSL = D / MOD_KS;
    for (int it = gw; it < NCG * MOD_KS; it += NGW) {
        const int cg = it % NCG, ks = it / NCG, col = cg * 64 + (lane & 15) * 4, kr = lane >> 4;
        f32x4 a0 = {0.f, 0.f, 0.f, 0.f}, a1 = {0.f, 0.f, 0.f, 0.f};
#pragma unroll
        for (int i = 0; i < KSL / 4; ++i) { const int k = ks * KSL + 4 * i + kr; const f32x4 w = *(const GAS f32x4*)(a.w_ada + (size_t)k * (NMOD * D) + col); a0 += w * cact[k]; a1 += w * cact[D + k]; }
#pragma unroll
        for (int c = 0; c < 4; ++c) { a0[c] += __shfl_xor(a0[c], 16); a0[c] += __shfl_xor(a0[c], 32); a1[c] += __shfl_xor(a1[c], 16); a1[c] += __shfl_xor(a1[c], 32); }
        if (kr == 0) { *(GAS f32x4*)(modpart + (size_t)(ks * 2 + 0) * (NMOD * D) + col) = a0; *(GAS f32x4*)(modpart + (size_t)(ks * 2 + 1) * (NMOD * D) + col) = a1; }
    }
    LAS float* scr = (LAS float*)(F.lds + 16384 + F.wave * 8704);
    constexpr int I_IN = (D / 64) * (DIN / 32), I_AO = (AW / 64) * (D / 32), I_CO = I_AO, I_O = (D / 64) * (D / 32);
    for (int it = gw; it < I_IN + I_AO + I_CO + I_O; it += NGW) {
        int r = it;
        if (r < I_IN) { const int nb = r % (DIN / 32), kb = r / (DIN / 32); transpose_item(a.w_in, D, DIN, (bf16_t*)(F.ws + WS_WIN), 64 * kb, 32 * nb, win_dest_row(32 * nb), scr, lane); continue; } r -= I_IN;
        if (r < I_AO) { const int nb = r % (D / 32), kb = r / (D / 32); transpose_item(a.w_attn_out, AW, D, (bf16_t*)(F.ws + WS_WAO), 64 * kb, 32 * nb, 32 * nb, scr, lane); continue; } r -= I_AO;
        if (r < I_CO) { const int nb = r % (D / 32), kb = r / (D / 32); transpose_item(a.w_conv_out, CWD, D, (bf16_t*)(F.ws + WS_WCO), 64 * kb, 32 * nb, 32 * nb, scr, lane); continue; } r -= I_CO;
        { const int nb = r % (D / 32), kb = r / (D / 32); transpose_item(a.w_o, D, D, (bf16_t*)(F.ws + WS_WO), 64 * kb, 32 * nb, 32 * nb, scr, lane); }
    }
    bf16_t* wrt = (bf16_t*)(F.ws + WS_WRT);
    for (int t = gw * 64 + lane; t < 48 * 128; t += NGW * 64) { const int kc = t / 48, c = t % 48; float v[8];
#pragma unroll
        for (int j = 0; j < 8; ++j) { const int k = kc * 8 + j; v[j] = c < NGRP ? a.w_rg[k * NGRP + c] : c < NGRP + NE ? a.w_re[k * NE + (c - NGRP)] : 0.f; }
        u32x4 o; o.x = cvt_pk_bf16(v[0], v[1]); o.y = cvt_pk_bf16(v[2], v[3]); o.z = cvt_pk_bf16(v[4], v[5]); o.w = cvt_pk_bf16(v[6], v[7]);
        *(GAS u32x4*)(wrt + (size_t)c * D + kc * 8) = o; }
}
__device__ __forceinline__ void p1_finalize(Frame& F, const Args& a) {
    const float* modpart = (const float*)(F.ws + WS_MODPART); float* modv = (float*)(F.ws + WS_MODV);
    for (int idx = F.tid * F.G + (int)blockIdx.x; idx < 2 * NMOD * D; idx += F.G * NTHR) {
        const int b = idx / (NMOD * D), j = idx % (NMOD * D), ch = j >> 10, k = j & 1023;
        float s = a.b_ada[j];
#pragma unroll
        for (int ks = 0; ks < MOD_KS; ++ks) s += modpart[(size_t)(ks * 2 + b) * (NMOD * D) + j];
        int v; float val = s;
        if (ch == 0) v = 1; else if (ch == 1) { v = 0; val = a.norm1_g[k] * (1.f + s); } else if (ch == 2) v = 2; else if (ch == 3) v = 4; else if (ch == 4) { v = 3; val = a.norm2_g[k] * (1.f + s); } else v = 5;
        modv[(size_t)(v * 2 + b) * D + k] = val;
    }
}
__device__ __forceinline__ void p2_h1_rows(Frame& F, const Args& a) {
    const float* modv = (const float*)(F.ws + WS_MODV);
    LAS float* mul = (LAS float*)F.lds; LAS float* add = mul + 2 * D;
    for (int i = F.tid; i < 2 * D / 4; i += NTHR) { *(LAS f32x4*)(mul + 4 * i) = *(const GAS f32x4*)(modv + 4 * i); *(LAS f32x4*)(add + 4 * i) = *(const GAS f32x4*)(modv + 2 * D + 4 * i); }
    __syncthreads();
    const int gw = F.vcu * NWAVES + F.wave, NGW = F.G * NWAVES, lane = F.lane;
    bf16_t* H1 = (bf16_t*)(F.ws + WS_R1);
    for (int m = gw; m < T; m += 2 * NGW) {
        const int m1 = (m + NGW < T) ? m + NGW : m;
        const GAS f32x4* xa = (const GAS f32x4*)(a.x + (size_t)m * D) + lane; const GAS f32x4* xb = (const GAS f32x4*)(a.x + (size_t)m1 * D) + lane;
        f32x4 va[4], vb[4]; float sa = 0.f, sb = 0.f;
#pragma unroll
        for (int j = 0; j < 4; ++j) { va[j] = xa[64 * j]; vb[j] = xb[64 * j]; }
#pragma unroll
        for (int j = 0; j < 4; ++j) { sa += (va[j].x * va[j].x + va[j].y * va[j].y) + (va[j].z * va[j].z + va[j].w * va[j].w); sb += (vb[j].x * vb[j].x + vb[j].y * vb[j].y) + (vb[j].z * vb[j].z + vb[j].w * vb[j].w); }
#pragma unroll
        for (int o = 1; o < 64; o <<= 1) { sa += __shfl_xor(sa, o); sb += __shfl_xor(sb, o); }
        const float ra = 1.f / sqrtf(sa * (1.f / D) + NORM_EPS), rb = 1.f / sqrtf(sb * (1.f / D) + NORM_EPS);
        const int ba = m / SEQ, bb = m1 / SEQ;
        GAS u32x2* oa = (GAS u32x2*)(H1 + (size_t)m * D) + lane; GAS u32x2* ob = (GAS u32x2*)(H1 + (size_t)m1 * D) + lane;
#pragma unroll
        for (int j = 0; j < 4; ++j) {
            const f32x4 ha = va[j] * ra * *(const LAS f32x4*)(mul + ba * D + 256 * j + 4 * lane) + *(const LAS f32x4*)(add + ba * D + 256 * j + 4 * lane);
            const f32x4 hb = vb[j] * rb * *(const LAS f32x4*)(mul + bb * D + 256 * j + 4 * lane) + *(const LAS f32x4*)(add + bb * D + 256 * j + 4 * lane);
            u32x2 o; o.x = cvt_pk_bf16(ha.x, ha.y); o.y = cvt_pk_bf16(ha.z, ha.w); oa[64 * j] = o;
            if (m1 != m) { u32x2 p; p.x = cvt_pk_bf16(hb.x, hb.y); p.y = cvt_pk_bf16(hb.z, hb.w); ob[64 * j] = p; } }
    }
}
struct EpiInProj {
    static constexpr bool PERM = true;
    bf16_t *Q, *Kb, *V, *U, *BG, *SA, *SC; const float* b_gate;
    __device__ __forceinline__ void operator()(const f32x4 (&acc)[2][2][4][2], const pg8::Unit& u, int wr, int wc, int fr, int fq) const {
        const int pn = u.pn, row0 = u.pm * 256 + wr * 64 + fr, colw = wc * 32 + 8 * fq;
        if (pn >= 6 && pn < 10) {
            const int ch0 = (pn - 6) * 128 + colw;
#pragma unroll
            for (int ai = 0; ai < 2; ++ai)
#pragma unroll
                for (int m = 0; m < 4; ++m) { const f32x4 v0 = acc[ai][0][m][0] * acc[ai][1][m][0], v1 = acc[ai][0][m][1] * acc[ai][1][m][1];
                    u32x4 w; w.x = cvt_pk_bf16(v0[0], v0[1]); w.y = cvt_pk_bf16(v0[2], v0[3]); w.z = cvt_pk_bf16(v1[0], v1[1]); w.w = cvt_pk_bf16(v1[2], v1[3]);
                    *(GAS u32x4*)(U + (size_t)(row0 + ai * 128 + m * 16) * 512 + ch0) = w; }
        } else if (pn >= 12) {
            bf16_t* dst = pn < 16 ? SA : SC; const int ct = (pn & 3) * 256, bt = (pn - 12) * 256;
#pragma unroll
            for (int bj = 0; bj < 2; ++bj) { const f32x4 b0 = *(const GAS f32x4*)(b_gate + bt + bj * 128 + colw), b1 = *(const GAS f32x4*)(b_gate + bt + bj * 128 + colw + 4);
#pragma unroll
                for (int ai = 0; ai < 2; ++ai)
#pragma unroll
                    for (int m = 0; m < 4; ++m) { const f32x4 v0 = acc[ai][bj][m][0] + b0, v1 = acc[ai][bj][m][1] + b1;
                        u32x4 w; w.x = cvt_pk_bf16(sigmoidf_(v0[0]), sigmoidf_(v0[1])); w.y = cvt_pk_bf16(sigmoidf_(v0[2]), sigmoidf_(v0[3]));
                        w.z = cvt_pk_bf16(sigmoidf_(v1[0]), sigmoidf_(v1[1])); w.w = cvt_pk_bf16(sigmoidf_(v1[2]), sigmoidf_(v1[3]));
                        *(GAS u32x4*)(dst + (size_t)(row0 + ai * 128 + m * 16) * 1024 + ct + bj * 128 + colw) = w; } }
        } else {
            bf16_t* dst = pn < 2 ? Q : pn < 4 ? Kb : pn < 6 ? V : BG; const float sc = pn < 2 ? QSCALE : 1.f; const int ct = (pn & 1) * 256;
#pragma unroll
            for (int ai = 0; ai < 2; ++ai)
#pragma unroll
                for (int m = 0; m < 4; ++m)
#pragma unroll
                    for (int bj = 0; bj < 2; ++bj) { const f32x4 v0 = acc[ai][bj][m][0] * sc, v1 = acc[ai][bj][m][1] * sc;
                        u32x4 w; w.x = cvt_pk_bf16(v0[0], v0[1]); w.y = cvt_pk_bf16(v0[2], v0[3]); w.z = cvt_pk_bf16(v1[0], v1[1]); w.w = cvt_pk_bf16(v1[2], v1[3]);
                        *(GAS u32x4*)(dst + (size_t)(row0 + ai * 128 + m * 16) * 512 + ct + bj * 128 + colw) = w; }
        }
    }
};

__device__ __forceinline__ void p3_kmean(Frame& F) {
    const bf16_t* Kb = (const bf16_t*)(F.ws + WS_K); float* kmean = (float*)(F.ws + WS_KMEAN);
    LAS float* red = (LAS float*)F.lds;
    for (int it = F.vcu; it < BATCH * NBLK * 4; it += F.G) {
        const int bn = it >> 2, cq = it & 3, cc = F.tid & 15, rg = F.tid >> 4;
        float s[8] = {0.f, 0.f, 0.f, 0.f, 0.f, 0.f, 0.f, 0.f};
#pragma unroll
        for (int r = 0; r < 8; ++r) { const u32x4 v = *(const GAS u32x4*)(Kb + (size_t)(bn * 256 + rg * 8 + r) * 512 + cq * 128 + cc * 8);
            s[0] += bf_lo(v.x); s[1] += bf_hi(v.x); s[2] += bf_lo(v.y); s[3] += bf_hi(v.y); s[4] += bf_lo(v.z); s[5] += bf_hi(v.z); s[6] += bf_lo(v.w); s[7] += bf_hi(v.w); }
#pragma unroll
        for (int j = 0; j < 8; ++j) red[rg * 128 + cc * 8 + j] = s[j];
        __syncthreads();
        if (F.tid < 128) { float t = 0.f;
#pragma unroll
            for (int g = 0; g < 32; ++g) t += red[g * 128 + F.tid];
            kmean[(size_t)bn * 512 + cq * 128 + F.tid] = t * (1.f / 256.f); }
        __syncthreads();
    }
}

__device__ __forceinline__ void p4_topk(Frame& F) {
    const bf16_t* Q = (const bf16_t*)(F.ws + WS_Q); const float* kmean = (const float*)(F.ws + WS_KMEAN);
    unsigned* qcnt = F.ctl + CW_QCNT; unsigned* list = (unsigned*)(F.ws + WS_LIST);
    LAS float* km = (LAS float*)F.lds;
    LAS unsigned* lcnt = (LAS unsigned*)(F.lds + 16384);
    LAS unsigned* lbase = lcnt + 64;
    for (int it = F.vcu; it < BATCH * (NBLK - 1) * 4; it += F.G) {
        const int hp = it & 3, qb = 1 + (it >> 2) % (NBLK - 1), b = (it >> 2) / (NBLK - 1);
        for (int i = F.tid; i < 2 * qb * 16; i += NTHR) { const int hl = i / (qb * 16), r = i % (qb * 16), n = r >> 4, c4 = r & 15;
            *(LAS f32x4*)(km + (hl * 32 + n) * 64 + c4 * 4) = *(const GAS f32x4*)(kmean + (size_t)(b * NBLK + n) * 512 + (2 * hp + hl) * 64 + c4 * 4); }
        if (F.tid < 128) lcnt[F.tid] = 0u;
        __syncthreads();
        const int ql = F.tid & 255, hl = F.tid >> 8, h = 2 * hp + hl, t = qb * 256 + ql;
        float q[64];
        { const GAS u32x4* qp = (const GAS u32x4*)(Q + (size_t)(b * SEQ + t) * 512 + h * 64);
#pragma unroll
          for (int c = 0; c < 8; ++c) { const u32x4 v = qp[c]; q[8 * c] = bf_lo(v.x); q[8 * c + 1] = bf_hi(v.x); q[8 * c + 2] = bf_lo(v.y); q[8 * c + 3] = bf_hi(v.y); q[8 * c + 4] = bf_lo(v.z); q[8 * c + 5] = bf_hi(v.z); q[8 * c + 6] = bf_lo(v.w); q[8 * c + 7] = bf_hi(v.w); } }
        float v0 = -3e38f, v1 = -3e38f, v2 = -3e38f; int i0 = 0, i1 = 0, i2 = 0;
#pragma unroll 2
        for (int n = 0; n < qb; ++n) {
            const LAS f32x4* kp = (const LAS f32x4*)(km + (hl * 32 + n) * 64); float g = 0.f;
#pragma unroll
            for (int c = 0; c < 16; ++c) { const f32x4 kv = kp[c]; g += q[4 * c] * kv.x + q[4 * c + 1] * kv.y + q[4 * c + 2] * kv.z + q[4 * c + 3] * kv.w; }
            if (g > v0) { v2 = v1; i2 = i1; v1 = v0; i1 = i0; v0 = g; i0 = n; }
            else if (g > v1) { v2 = v1; i2 = i1; v1 = g; i1 = n; }
            else if (g > v2) { v2 = g; i2 = n; }
        }
        const int nsel = qb < TOPK ? qb : TOPK;
        unsigned p0 = 0, p1 = 0, p2 = 0;
        p0 = __hip_atomic_fetch_add(&lcnt[hl * 32 + i0], 1u, __ATOMIC_RELAXED, __HIP_MEMORY_SCOPE_WORKGROUP);
        if (nsel > 1) p1 = __hip_atomic_fetch_add(&lcnt[hl * 32 + i1], 1u, __ATOMIC_RELAXED, __HIP_MEMORY_SCOPE_WORKGROUP);
        if (nsel > 2) p2 = __hip_atomic_fetch_add(&lcnt[hl * 32 + i2], 1u, __ATOMIC_RELAXED, __HIP_MEMORY_SCOPE_WORKGROUP);
        __syncthreads();
        if (F.tid < 64) { const int hl2 = F.tid >> 5, n = F.tid & 31; const unsigned c = lcnt[F.tid];
            lbase[F.tid] = c ? atomicAdd(&qcnt[(b * NH + 2 * hp + hl2) * NBLK + n], c) : 0u; }
        __syncthreads();
        const size_t lb = (size_t)((b * NH + h) * NBLK);
        list[(lb + i0) * CAPQ + lbase[hl * 32 + i0] + p0] = (unsigned)t | (0u << 13);
        if (nsel > 1) list[(lb + i1) * CAPQ + lbase[hl * 32 + i1] + p1] = (unsigned)t | (1u << 13);
        if (nsel > 2) list[(lb + i2) * CAPQ + lbase[hl * 32 + i2] + p2] = (unsigned)t | (2u << 13);
        __syncthreads();
    }
}

__device__ __forceinline__ int crow(int r, int hi) { return (r & 3) + 8 * (r >> 2) + 4 * hi; }
__device__ __forceinline__ float swap_max(float m) { auto rr = __builtin_amdgcn_permlane32_swap(__float_as_uint(m), __float_as_uint(m), false, false); return fmaxf(__uint_as_float(rr[0]), __uint_as_float(rr[1])); }
__device__ __forceinline__ float swap_sum(float m) { auto rr = __builtin_amdgcn_permlane32_swap(__float_as_uint(m), __float_as_uint(m), false, false); return __uint_as_float(rr[0]) + __uint_as_float(rr[1]); }
__device__ __forceinline__ s16x4 vtr(const LAS unsigned char* p) { return __builtin_bit_cast(s16x4, __builtin_amdgcn_ds_read_tr16_b64_v4i16((LAS s16x4*)p)); }
constexpr int AT_KV = 0, AT_OST = 131072, AT_LW = 147456, AT_META = 148480, AT_TAB = 149504, AT_PFX = 153728;
struct AttItem { int idx, j, own, nvalid; };
__device__ __forceinline__ AttItem att_decode(const LAS int* pfx, const unsigned* qcnt, int it) {
    int lo = 0, hh = 511;
#pragma unroll 1
    while (lo < hh) { const int mid = (lo + hh + 1) >> 1; if (pfx[mid] <= it) lo = mid; else hh = mid - 1; }
    AttItem r; r.idx = lo; r.j = it - pfx[lo]; const int nch = pfx[lo + 1] - pfx[lo] - 1; r.own = (r.j == nch);
    const int rem = (int)qcnt[lo] - r.j * 256; r.nvalid = r.own ? 256 : (rem < 256 ? rem : 256); return r;
}
__device__ __forceinline__ void att_dma(const bf16_t* Kb, const bf16_t* V, LAS unsigned char* dst, int idx, int w, int lane) {
    const int n = idx & 31, h = (idx >> 5) & 7, b = idx >> 8; const size_t g0 = ((size_t)(b * SEQ + n * 256)) * 512 + h * 64;
    const int rowl = lane >> 3, pc = lane & 7;
#pragma unroll
    for (int q = 0; q < 4; ++q) { const int row = 8 * (4 * w + q) + rowl;
        __builtin_amdgcn_global_load_lds((const unsigned*)(Kb + g0 + (size_t)row * 512 + ((pc ^ ((row >> 1) & 7)) << 3)), (LAS unsigned*)(dst + (4 * w + q) * 1024), 16, 0, 0);
        __builtin_amdgcn_global_load_lds((const unsigned*)(V + g0 + (size_t)row * 512 + ((pc ^ (((row >> 1) & 1) << 2)) << 3)), (LAS unsigned*)(dst + 32768 + (4 * w + q) * 1024), 16, 0, 0); }
}
__device__ __forceinline__ void p5_attention(Frame& F, const Args& a) {
    const bf16_t* Q = (const bf16_t*)(F.ws + WS_Q); const bf16_t* Kb = (const bf16_t*)(F.ws + WS_K); const bf16_t* V = (const bf16_t*)(F.ws + WS_V);
    bf16_t* OP = (bf16_t*)(F.ws + WS_OPART); float* ML = (float*)(F.ws + WS_ML);
    const unsigned* qcnt = F.ctl + CW_QCNT; const unsigned* list = (const unsigned*)(F.ws + WS_LIST);
    LAS unsigned char* lds = F.lds; const int tid = F.tid, lane = F.lane, w = F.wave, r32 = lane & 31, hi = lane >> 5;
    LAS float* tab = (LAS float*)(lds + AT_TAB); LAS int* pfx = (LAS int*)(lds + AT_PFX);
    for (int i = tid; i < NH * 132; i += NTHR) { const int h = i / 132, e = i % 132; float v = 0.f;
        if (e == 0) v = -INFINITY;
        else if (e <= 128) { const int d = e - 1; int bk;
            if (d < 16) bk = d; else { bk = 16 + (d >= 19) + (d >= 21) + (d >= 24) + (d >= 27) + (d >= 31) + (d >= 35) + (d >= 40) + (d >= 46) + (d >= 52) + (d >= 59) + (d >= 67) + (d >= 77) + (d >= 87) + (d >= 99) + (d >= 113); }
            v = (a.rel_bias[bk * NH + h] - a.rel_bias[31 * NH + h]) * LOG2E; }
        else if (e == 130) v = a.rel_bias[31 * NH + h] * LOG2E;
        tab[i] = v; }
    { const int c = (int)qcnt[tid]; pfx[tid + 1] = (c + 255) / 256 + 1; if (tid == 0) pfx[0] = 0; }
    __syncthreads();
    for (int o = 1; o < 512; o <<= 1) { int v = pfx[tid + 1]; if (tid >= o) v += pfx[tid + 1 - o]; __syncthreads(); pfx[tid + 1] = v; __syncthreads(); }
    const int nitems = pfx[512];
    LAS float* lw = (LAS float*)(lds + AT_LW) + w * 32; LAS unsigned* meta = (LAS unsigned*)(lds + AT_META) + w * 32;
    LAS bf16_t* stg = (LAS bf16_t*)(lds + AT_OST) + w * 1024;
    int it = F.vcu; int buf = 0;
    AttItem cur; cur.idx = 0; cur.j = 0; cur.own = 0; cur.nvalid = 0;
    if (it < nitems) { cur = att_decode(pfx, qcnt, it); att_dma(Kb, V, lds + AT_KV, cur.idx, w, lane); }
    for (; it < nitems; it += F.G, buf ^= 1) {
        const int idx = cur.idx, j = cur.j; const bool own = cur.own != 0; const int nvalid = cur.nvalid;
        const int n = idx & 31, h = (idx >> 5) & 7, b = idx >> 8;
        const int rowi = 32 * w + r32; const bool valid = rowi < nvalid;
        const unsigned ent = own ? ((unsigned)(n * 256 + rowi) | (3u << 13)) : list[(size_t)idx * CAPQ + j * 256 + (valid ? rowi : 0)];
        const int tq = (int)(ent & 8191u), slot = (int)(ent >> 13) & 3;
        if (hi == 0) meta[r32] = (unsigned)tq | ((unsigned)slot << 13) | (valid ? 0x8000u : 0u);
        __syncthreads();
        const bool has_next = it + F.G < nitems;
        AttItem nxt = cur; if (has_next) nxt = att_decode(pfx, qcnt, it + F.G);
        const LAS unsigned char* kt = lds + AT_KV + buf * 65536; const LAS unsigned char* vt = kt + 32768;
        if (32 * w < nvalid) {
            bf16x8 qf[4];
            { const GAS bf16x8* qp = (const GAS bf16x8*)(Q + (size_t)(b * SEQ + tq) * 512 + h * 64 + 8 * hi);
#pragma unroll
              for (int s = 0; s < 4; ++s) qf[s] = qp[2 * s]; }
            asm volatile("" :: "v"(qf[0]), "v"(qf[1]), "v"(qf[2]), "v"(qf[3]));
            if (has_next) att_dma(Kb, V, lds + AT_KV + (buf ^ 1) * 65536, nxt.idx, w, lane);
            const int imax = own ? w : 7;
            f32x16 p[8];
#pragma unroll
            for (int i = 0; i < 8; ++i) if (i <= imax) { const int row = 32 * i + r32; const LAS unsigned char* kr = kt + row * 128; const int sw = (row >> 1) & 7;
                f32x16 accp = {0.f, 0.f, 0.f, 0.f, 0.f, 0.f, 0.f, 0.f, 0.f, 0.f, 0.f, 0.f, 0.f, 0.f, 0.f, 0.f};
#pragma unroll
                for (int s = 0; s < 4; ++s) { const bf16x8 kf = *(const LAS bf16x8*)(kr + (((2 * s + hi) ^ sw) << 4)); accp = __builtin_amdgcn_mfma_f32_32x32x16_bf16(kf, qf[s], accp, 0, 0, 0); }
                p[i] = accp; }
            const int kbase = n * 256; const LAS float* tb = tab + h * 132; const int dq = tq - kbase - 4 * hi + 1;
#pragma unroll
            for (int i = 0; i < 8; ++i) if (i <= imax) {
                if (__any(valid && (tq - kbase - 32 * i - 31 < 127))) {
#pragma unroll
                    for (int r = 0; r < 16; ++r) { int di = dq - 32 * i - ((r & 3) + 8 * (r >> 2)); di = di < 0 ? 0 : (di > 128 ? 128 : di); p[i][r] += tb[di]; } } }
            float mx = -INFINITY;
#pragma unroll
            for (int i = 0; i < 8; ++i) if (i <= imax) {
#pragma unroll
                for (int r = 0; r < 16; ++r) mx = fmaxf(mx, p[i][r]); }
            mx = swap_max(mx);
            float ls = 0.f;
#pragma unroll
            for (int i = 0; i < 8; ++i) if (i <= imax) {
#pragma unroll
                for (int r = 0; r < 16; ++r) { const float e = __builtin_amdgcn_exp2f(p[i][r] - mx); p[i][r] = e; ls += e; } }
            ls = swap_sum(ls);
            f32x16 o0 = {0.f, 0.f, 0.f, 0.f, 0.f, 0.f, 0.f, 0.f, 0.f, 0.f, 0.f, 0.f, 0.f, 0.f, 0.f, 0.f}, o1 = o0;
            { const int L = lane & 15, qq = L >> 2, pp = L & 3, sq = (qq >> 1) & 1, cc = 2 * ((lane >> 4) & 1) + (pp >> 1);
              const LAS unsigned char* vb0 = vt + (4 * hi + qq) * 128 + ((4 * sq + cc) << 4) + (pp & 1) * 8;
              const LAS unsigned char* vb1 = vt + (4 * hi + qq) * 128 + ((4 * (1 ^ sq) + cc) << 4) + (pp & 1) * 8;
#pragma unroll
              for (int i = 0; i < 8; ++i) if (i <= imax) {
#pragma unroll
                  for (int s2 = 0; s2 < 2; ++s2) {
                      u32x4 pw; pw.x = cvt_pk_bf16(p[i][8 * s2 + 0], p[i][8 * s2 + 1]); pw.y = cvt_pk_bf16(p[i][8 * s2 + 2], p[i][8 * s2 + 3]); pw.z = cvt_pk_bf16(p[i][8 * s2 + 4], p[i][8 * s2 + 5]); pw.w = cvt_pk_bf16(p[i][8 * s2 + 6], p[i][8 * s2 + 7]);
                      const bf16x8 pa = __builtin_bit_cast(bf16x8, pw); const int off = (32 * i + 16 * s2) * 128;
                      const s16x4 a0 = vtr(vb0 + off), a1 = vtr(vb0 + off + 1024), c0 = vtr(vb1 + off), c1 = vtr(vb1 + off + 1024);
                      const bf16x8 vf0 = {a0[0], a0[1], a0[2], a0[3], a1[0], a1[1], a1[2], a1[3]}, vf1 = {c0[0], c0[1], c0[2], c0[3], c1[0], c1[1], c1[2], c1[3]};
                      o0 = __builtin_amdgcn_mfma_f32_32x32x16_bf16(pa, vf0, o0, 0, 0, 0); o1 = __builtin_amdgcn_mfma_f32_32x32x16_bf16(pa, vf1, o1, 0, 0, 0); } } }
            if (hi == 0) { lw[r32] = ls; if (valid) ML[((size_t)(b * SEQ + tq) * NH + h) * 4 + slot] = mx + __builtin_amdgcn_logf(ls) + tb[130]; }
            LDS_WAIT();
            float rl[16];
#pragma unroll
            for (int r = 0; r < 16; ++r) rl[r] = __builtin_amdgcn_rcpf(lw[crow(r, hi)]);
#pragma unroll
            for (int d0 = 0; d0 < 2; ++d0) {
#pragma unroll
                for (int r = 0; r < 16; ++r) stg[crow(r, hi) * 32 + r32] = (bf16_t)(cvt_pk_bf16((d0 ? o1[r] : o0[r]) * rl[r], 0.f) & 0xffffu);
                LDS_WAIT();
#pragma unroll
                for (int i = 0; i < 2; ++i) { const int id = lane + 64 * i, row = id >> 2, ch = id & 3; const unsigned mt = meta[row];
                    if (mt & 0x8000u) { const u32x4 v = *(const LAS u32x4*)(stg + row * 32 + ch * 8); const int tt = (int)(mt & 8191u), sl = (int)(mt >> 13) & 3;
                        *(GAS u32x4*)(OP + (((size_t)(b * SEQ + tt) * NH + h) * 4 + sl) * 64 + d0 * 32 + ch * 8) = v; } }
                LDS_WAIT();
            }
        } else if (has_next) att_dma(Kb, V, lds + AT_KV + (buf ^ 1) * 65536, nxt.idx, w, lane);
        cur = nxt;
    }
    __syncthreads();
}

__device__ __forceinline__ void p6_combine_conv(Frame& F, const Args& a) {
    const bf16_t* OP = (const bf16_t*)(F.ws + WS_OPART); const float* ML = (const float*)(F.ws + WS_ML);
    const bf16_t* U = (const bf16_t*)(F.ws + WS_U); const bf16_t* BG = (const bf16_t*)(F.ws + WS_BG);
    bf16_t* ATT = (bf16_t*)(F.ws + WS_R1); bf16_t* CV = ATT + (size_t)T * 512;
    const int gw = F.vcu * NWAVES + F.wave, NGW = F.G * NWAVES, lane = F.lane;
    float cw[3][8];
#pragma unroll
    for (int j = 0; j < 3; ++j)
#pragma unroll
        for (int c = 0; c < 8; ++c) cw[j][c] = a.conv_w[j * CWD + lane * 8 + c];
    const int hd = lane >> 3, ch = lane & 7;
    for (int t0 = gw; t0 < T; t0 += 2 * NGW) {
        int tg[2]; tg[0] = t0; tg[1] = (t0 + NGW < T) ? t0 + NGW : t0;
        f32x4 l4[2]; u32x4 ov[2][4], uv[2][3], gv[2];
#pragma unroll
        for (int q = 0; q < 2; ++q) { const int tb = tg[q] & (SEQ - 1), qb = tb >> 8, nsel = qb < TOPK ? qb : TOPK; const size_t pb = ((size_t)tg[q] * NH + hd) * 4;
            l4[q] = *(const GAS f32x4*)(ML + pb);
#pragma unroll
            for (int sl = 0; sl < 4; ++sl) ov[q][sl] = (sl == 3 || sl < nsel) ? *(const GAS u32x4*)(OP + (pb + sl) * 64 + ch * 8) : (u32x4){0u, 0u, 0u, 0u};
            uv[q][2] = *(const GAS u32x4*)(U + (size_t)tg[q] * 512 + lane * 8);
            uv[q][1] = tb >= 1 ? *(const GAS u32x4*)(U + (size_t)(tg[q] - 1) * 512 + lane * 8) : (u32x4){0u, 0u, 0u, 0u};
            uv[q][0] = tb >= 2 ? *(const GAS u32x4*)(U + (size_t)(tg[q] - 2) * 512 + lane * 8) : (u32x4){0u, 0u, 0u, 0u};
            gv[q] = *(const GAS u32x4*)(BG + (size_t)tg[q] * 512 + lane * 8); }
#pragma unroll
        for (int q = 0; q < 2; ++q) if (q == 0 || tg[1] != tg[0]) { const int tb = tg[q] & (SEQ - 1), qb = tb >> 8, nsel = qb < TOPK ? qb : TOPK;
            const float ls[4] = {l4[q].x, l4[q].y, l4[q].z, l4[q].w}; float M = ls[3];
#pragma unroll
            for (int sl = 0; sl < 3; ++sl) if (sl < nsel) M = fmaxf(M, ls[sl]);
            float acc[8] = {0.f, 0.f, 0.f, 0.f, 0.f, 0.f, 0.f, 0.f}; float W = 0.f;
#pragma unroll
            for (int sl = 0; sl < 4; ++sl) if (sl == 3 || sl < nsel) { const float wg = __builtin_amdgcn_exp2f(ls[sl] - M); W += wg; const u32x4 v = ov[q][sl];
                acc[0] += wg * bf_lo(v.x); acc[1] += wg * bf_hi(v.x); acc[2] += wg * bf_lo(v.y); acc[3] += wg * bf_hi(v.y); acc[4] += wg * bf_lo(v.z); acc[5] += wg * bf_hi(v.z); acc[6] += wg * bf_lo(v.w); acc[7] += wg * bf_hi(v.w); }
            const float rW = 1.f / W;
            { u32x4 o; o.x = cvt_pk_bf16(acc[0] * rW, acc[1] * rW); o.y = cvt_pk_bf16(acc[2] * rW, acc[3] * rW); o.z = cvt_pk_bf16(acc[4] * rW, acc[5] * rW); o.w = cvt_pk_bf16(acc[6] * rW, acc[7] * rW);
              *(GAS u32x4*)(ATT + (size_t)tg[q] * 512 + lane * 8) = o; }
            float y[8] = {0.f, 0.f, 0.f, 0.f, 0.f, 0.f, 0.f, 0.f};
#pragma unroll
            for (int j = 0; j < 3; ++j) { const u32x4 v = uv[q][j];
                y[0] += cw[j][0] * bf_lo(v.x); y[1] += cw[j][1] * bf_hi(v.x); y[2] += cw[j][2] * bf_lo(v.y); y[3] += cw[j][3] * bf_hi(v.y); y[4] += cw[j][4] * bf_lo(v.z); y[5] += cw[j][5] * bf_hi(v.z); y[6] += cw[j][6] * bf_lo(v.w); y[7] += cw[j][7] * bf_hi(v.w); }
            { const u32x4 g = gv[q];
              u32x4 o; o.x = cvt_pk_bf16(y[0] * bf_lo(g.x), y[1] * bf_hi(g.x)); o.y = cvt_pk_bf16(y[2] * bf_lo(g.y), y[3] * bf_hi(g.y)); o.z = cvt_pk_bf16(y[4] * bf_lo(g.z), y[5] * bf_hi(g.z)); o.w = cvt_pk_bf16(y[6] * bf_lo(g.w), y[7] * bf_hi(g.w));
              *(GAS u32x4*)(CV + (size_t)tg[q] * 512 + lane * 8) = o; } }
    }
}

template <bool ADD> struct EpiGate {
    static constexpr bool PERM = true;
    bf16_t* MG; const bf16_t* S;
    __device__ __forceinline__ void operator()(const f32x4 (&acc)[2][2][4][2], const pg8::Unit& u, int wr, int wc, int fr, int fq) const {
        const int row0 = u.pm * 256 + wr * 64 + fr, col0 = u.pn * 256 + wc * 32 + 8 * fq;
#pragma unroll
        for (int ai = 0; ai < 2; ++ai)
#pragma unroll
            for (int m = 0; m < 4; ++m)
#pragma unroll
                for (int bj = 0; bj < 2; ++bj) { const size_t off = (size_t)(row0 + ai * 128 + m * 16) * 1024 + col0 + bj * 128;
                    const u32x4 g = *(const GAS u32x4*)(S + off); const f32x4 a0 = acc[ai][bj][m][0], a1 = acc[ai][bj][m][1];
                    float v[8] = {a0[0] * bf_lo(g.x), a0[1] * bf_hi(g.x), a0[2] * bf_lo(g.y), a0[3] * bf_hi(g.y), a1[0] * bf_lo(g.z), a1[1] * bf_hi(g.z), a1[2] * bf_lo(g.w), a1[3] * bf_hi(g.w)};
                    if constexpr (ADD) { const u32x4 pz = *(const GAS u32x4*)(MG + off);
                        v[0] += bf_lo(pz.x); v[1] += bf_hi(pz.x); v[2] += bf_lo(pz.y); v[3] += bf_hi(pz.y); v[4] += bf_lo(pz.z); v[5] += bf_hi(pz.z); v[6] += bf_lo(pz.w); v[7] += bf_hi(pz.w); }
                    u32x4 w; w.x = cvt_pk_bf16(v[0], v[1]); w.y = cvt_pk_bf16(v[2], v[3]); w.z = cvt_pk_bf16(v[4], v[5]); w.w = cvt_pk_bf16(v[6], v[7]);
                    *(GAS u32x4*)(MG + off) = w; }
    }
};
struct EpiResid {
    static constexpr bool PERM = false;
    const float* x; float* X1; const float* g1;
    __device__ __forceinline__ void operator()(const f32x4 (&acc)[2][2][4][2], const pg8::Unit& u, int wr, int wc, int fr, int fq) const {
        const int row0 = u.pm * 256 + wr * 64 + fr, col0 = u.pn * 256 + wc * 32 + 4 * fq; const int b = (u.pm * 256) / SEQ;
        f32x4 gv[2][2];
#pragma unroll
        for (int bj = 0; bj < 2; ++bj)
#pragma unroll
            for (int n = 0; n < 2; ++n) gv[bj][n] = *(const GAS f32x4*)(g1 + (size_t)b * D + col0 + bj * 128 + n * 16);
#pragma unroll
        for (int ai = 0; ai < 2; ++ai)
#pragma unroll
            for (int m = 0; m < 4; ++m) { const size_t ro = (size_t)(row0 + ai * 128 + m * 16) * D + col0;
#pragma unroll
                for (int bj = 0; bj < 2; ++bj)
#pragma unroll
                    for (int n = 0; n < 2; ++n) { const f32x4 xv = *(const GAS f32x4*)(x + ro + bj * 128 + n * 16); *(GAS f32x4*)(X1 + ro + bj * 128 + n * 16) = xv + gv[bj][n] * acc[ai][bj][m][n]; } }
    }
};

__device__ __forceinline__ void p9_norm_route(Frame& F, const Args& a) {
    const int gw = F.vcu * NWAVES + F.wave, NGW = F.G * NWAVES, lane = F.lane, tid = F.tid;
#ifndef PROBE_PH
#define PROBE_PH (-1)
#endif
    for (int rep_ = 0; rep_ < ((PROBE_PH) == 90 ? 2 : 1); ++rep_)
    {
        LAS float* scr = (LAS float*)(F.lds + F.wave * 8704);
        constexpr int I_G = (D / 64) * (DE / 32), I_D = (DE / 64) * (D / 32), PER_E = 2 * I_G + I_D;
        for (int it = gw; it < NE * PER_E; it += NGW) {
            const int e = it / PER_E; int r = it % PER_E;
            bf16_t* wgu = (bf16_t*)(F.ws + WS_WGU) + (size_t)e * 1024 * 1024; bf16_t* wd = (bf16_t*)(F.ws + WS_WD) + (size_t)e * 1024 * 512;
            if (r < 2 * I_G) { const int up = r >= I_G; if (up) r -= I_G; const int nb = r % (DE / 32), kb = r / (DE / 32), n0 = 32 * nb;
                transpose_item((up ? a.w_eu : a.w_eg) + (size_t)e * D * DE, D, DE, wgu, 64 * kb, n0, 256 * (n0 >> 7) + (n0 & 127) + (up ? 128 : 0), scr, lane); }
            else { r -= 2 * I_G; const int nb = r % (D / 32), kb = r / (D / 32); transpose_item(a.w_ed + (size_t)e * DE * D, DE, D, wd, 64 * kb, 32 * nb, 32 * nb, scr, lane); }
        }
    }
    __syncthreads();
    LAS unsigned char* wrl = F.lds;
    LAS float* mul = (LAS float*)(F.lds + 99328); LAS float* add = mul + 2 * D;
    LAS float* ssq = (LAS float*)(F.lds + 115712);
    LAS float* lgx = (LAS float*)(F.lds + 116224);
    LAS float* rb = (LAS float*)(F.lds + 140800);
    LAS int* asg_e = (LAS int*)(F.lds + 141056);
    LAS unsigned* asg_p = (LAS unsigned*)(asg_e + 128);
    LAS float* asg_w = (LAS float*)(asg_p + 128);
    LAS unsigned* lcnt = (LAS unsigned*)(asg_w + 128);
    LAS unsigned* lbase = lcnt + 32;
    { const bf16_t* wrt = (const bf16_t*)(F.ws + WS_WRT); const float* modv = (const float*)(F.ws + WS_MODV);
#pragma unroll
      for (int i = 0; i < 12; ++i) { const int id = tid + NTHR * i, c = id >> 7, kc = id & 127; *(LAS u32x4*)(wrl + (c * 1032 + kc * 8) * 2) = *(const GAS u32x4*)(wrt + (size_t)c * D + kc * 8); }
      *(LAS f32x4*)(mul + 4 * tid) = *(const GAS f32x4*)(modv + 6 * D + 4 * tid); *(LAS f32x4*)(add + 4 * tid) = *(const GAS f32x4*)(modv + 8 * D + 4 * tid);
      if (tid < 48) rb[tid] = tid < NGRP ? a.b_rg[tid] : tid < NGRP + NE ? a.b_re[tid - NGRP] : 0.f; }
    __syncthreads();
    const float* X1 = a.out; bf16_t* H2 = (bf16_t*)(F.ws + WS_R1);
    int* tok_e = (int*)(F.ws + WS_TOKE); int* tok_p = (int*)(F.ws + WS_TOKP); int* rowidx = (int*)(F.ws + WS_ROWIDX); float* roww = (float*)(F.ws + WS_ROWW);
    unsigned* ecnt = F.ctl + CW_ECNT;
    const int wv = F.wave, tile = wv & 3, half = wv >> 2, r = lane & 15, kq = lane >> 4;
    for (int rbk = F.vcu; rbk < T / 64; rbk += F.G) {
        if (tid < 32) lcnt[tid] = 0u;
        const int m0 = rbk * 64 + tile * 16, b = m0 / SEQ, kb = half * 512 + 8 * kq;
        const float* xr = X1 + (size_t)(m0 + r) * D + kb;
        f32x4 xa[16], xb[16];
#pragma unroll
        for (int sx = 0; sx < 16; ++sx) { xa[sx] = *(const GAS f32x4*)(xr + 32 * sx); xb[sx] = *(const GAS f32x4*)(xr + 32 * sx + 4); }
        float ss = 0.f;
#pragma unroll
        for (int sx = 0; sx < 16; ++sx) ss += (xa[sx].x * xa[sx].x + xa[sx].y * xa[sx].y) + (xa[sx].z * xa[sx].z + xa[sx].w * xa[sx].w) + (xb[sx].x * xb[sx].x + xb[sx].y * xb[sx].y) + (xb[sx].z * xb[sx].z + xb[sx].w * xb[sx].w);
        ss += __shfl_xor(ss, 16); ss += __shfl_xor(ss, 32);
        if (kq == 0) ssq[wv * 16 + r] = ss;
        __syncthreads();
        const float rstd = 1.f / sqrtf((ssq[wv * 16 + r] + ssq[(wv ^ 4) * 16 + r]) * (1.f / D) + NORM_EPS);
        f32x4 acc[3] = {{0.f, 0.f, 0.f, 0.f}, {0.f, 0.f, 0.f, 0.f}, {0.f, 0.f, 0.f, 0.f}};
        bf16_t* hrow = H2 + (size_t)(m0 + r) * D + kb;
#pragma unroll
        for (int sx = 0; sx < 16; ++sx) { const int kk = kb + 32 * sx;
            const f32x4 ml = *(const LAS f32x4*)(mul + b * D + kk), mh = *(const LAS f32x4*)(mul + b * D + kk + 4), al = *(const LAS f32x4*)(add + b * D + kk), ah = *(const LAS f32x4*)(add + b * D + kk + 4);
            const f32x4 hl = xa[sx] * rstd * ml + al, hh = xb[sx] * rstd * mh + ah;
            u32x4 hw; hw.x = cvt_pk_bf16(hl.x, hl.y); hw.y = cvt_pk_bf16(hl.z, hl.w); hw.z = cvt_pk_bf16(hh.x, hh.y); hw.w = cvt_pk_bf16(hh.z, hh.w);
            *(GAS u32x4*)(hrow + 32 * sx) = hw;
            const bf16x8 hf = __builtin_bit_cast(bf16x8, hw);
#pragma unroll
            for (int nt = 0; nt < 3; ++nt) { const bf16x8 wf = *(const LAS bf16x8*)(wrl + ((16 * nt + r) * 1032 + kk) * 2); acc[nt] = __builtin_amdgcn_mfma_f32_16x16x32_bf16(hf, wf, acc[nt], 0, 0, 0); } }
#pragma unroll
        for (int nt = 0; nt < 3; ++nt)
#pragma unroll
            for (int j = 0; j < 4; ++j) lgx[(wv * 16 + 4 * kq + j) * 48 + 16 * nt + r] = acc[nt][j];
        __syncthreads();
        if (tid < 64) {
            const int tl = tid >> 4, rw = tid & 15; float lg[36];
#pragma unroll
            for (int c4 = 0; c4 < 9; ++c4) { const f32x4 p = *(const LAS f32x4*)(lgx + (tl * 16 + rw) * 48 + 4 * c4), q = *(const LAS f32x4*)(lgx + ((tl + 4) * 16 + rw) * 48 + 4 * c4), bz = *(const LAS f32x4*)(rb + 4 * c4);
                lg[4 * c4] = p.x + q.x + bz.x; lg[4 * c4 + 1] = p.y + q.y + bz.y; lg[4 * c4 + 2] = p.z + q.z + bz.z; lg[4 * c4 + 3] = p.w + q.w + bz.w; }
            int gs = 0; float gm = lg[0];
#pragma unroll
            for (int g = 1; g < 4; ++g) if (lg[g] > gm) { gm = lg[g]; gs = g; }
            float gden = 0.f;
#pragma unroll
            for (int g = 0; g < 4; ++g) gden += __expf(lg[g] - gm);
            const float g_w = 1.f / gden;
            float el[8];
#pragma unroll
            for (int j = 0; j < 8; ++j) el[j] = gs == 0 ? lg[4 + j] : gs == 1 ? lg[12 + j] : gs == 2 ? lg[20 + j] : lg[28 + j];
            int i0 = 0; float m0v = el[0];
#pragma unroll
            for (int j = 1; j < 8; ++j) if (el[j] > m0v) { m0v = el[j]; i0 = j; }
            int i1 = -1; float m1v = -3e38f;
#pragma unroll
            for (int j = 0; j < 8; ++j) if (j != i0 && el[j] > m1v) { m1v = el[j]; i1 = j; }
            const float e1 = __expf(m1v - m0v), w0 = g_w / (1.f + e1), w1 = g_w * e1 / (1.f + e1);
            asg_e[tid * 2] = gs * 8 + i0; asg_e[tid * 2 + 1] = gs * 8 + i1; asg_w[tid * 2] = w0; asg_w[tid * 2 + 1] = w1;
        }
        __syncthreads();
        if (tid < 128) asg_p[tid] = __hip_atomic_fetch_add(&lcnt[asg_e[tid]], 1u, __ATOMIC_RELAXED, __HIP_MEMORY_SCOPE_WORKGROUP);
        __syncthreads();
        if (tid < 32) { const unsigned c = lcnt[tid]; lbase[tid] = c ? atomicAdd(&ecnt[tid], c) : 0u; }
        __syncthreads();
        if (tid < 128) { const int m = rbk * 64 + (tid >> 1), e = asg_e[tid]; const int pos = (int)(lbase[e] + asg_p[tid]);
            tok_e[m * 2 + (tid & 1)] = e; tok_p[m * 2 + (tid & 1)] = pos; rowidx[(size_t)e * ECAP + pos] = m; roww[(size_t)e * ECAP + pos] = asg_w[tid]; }
        __syncthreads();
    }
}

struct MoeOrder {
    const LAS int* tpre;
    const LAS int* cnts;
    const LAS int* rowtab;
    const char* A; const char* B; size_t a_tile_bytes, b_exp_bytes, b_tile_bytes; int G, c, nunits;
    __device__ bool next(int i, pg8::Unit& u) const {
        const long L = (long)i * G + c; if (L >= nunits) return false;
        int wgid = (int)L; { const int q = nunits / 8, r = nunits % 8, xcd = wgid % 8, off = wgid / 8; wgid = (xcd < r ? xcd * (q + 1) : r * (q + 1) + (xcd - r) * q) + off; }
        const int ti = wgid >> 2; u.pn = wgid & 3; u.pm = ti;
        int e = 0;
#pragma unroll 1
        for (int s = 16; s >= 1; s >>= 1) if (tpre[e + s] <= ti) e += s;
        u.e = e; const int r0 = (ti - tpre[e]) * 256; u.nvalid = cnts[e] - r0 < 256 ? cnts[e] - r0 : 256;
        u.A = A + (size_t)ti * a_tile_bytes; u.B = B + (size_t)e * b_exp_bytes + (size_t)u.pn * b_tile_bytes; return true;
    }
    __device__ __forceinline__ unsigned arow(int i, int r) const { return (unsigned)rowtab[(i & 7) * 256 + r]; }
};
__device__ __forceinline__ int moe_setup(Frame& F, LAS int* tpre, LAS int* cnts) {
    const unsigned* ecnt = F.ctl + CW_ECNT;
    if (F.tid == 0) { int acc = 0; for (int e = 0; e < NE; ++e) { const int c = (int)ecnt[e]; cnts[e] = c; tpre[e] = acc; acc += (c + 255) >> 8; } tpre[NE] = acc; }
    __syncthreads();
    return tpre[NE];
}
struct EpiSwiglu {
    static constexpr bool PERM = true;
    bf16_t* ACT;
    __device__ __forceinline__ void operator()(const f32x4 (&acc)[2][2][4][2], const pg8::Unit& u, int wr, int wc, int fr, int fq) const {
        const int row0 = u.pm * 256 + wr * 64 + fr, ch0 = u.pn * 128 + wc * 32 + 8 * fq;
#pragma unroll
        for (int ai = 0; ai < 2; ++ai)
#pragma unroll
            for (int m = 0; m < 4; ++m) { const f32x4 g0 = acc[ai][0][m][0], g1 = acc[ai][0][m][1], u0 = acc[ai][1][m][0], u1 = acc[ai][1][m][1];
                u32x4 w; w.x = cvt_pk_bf16(silu_(g0[0]) * u0[0], silu_(g0[1]) * u0[1]); w.y = cvt_pk_bf16(silu_(g0[2]) * u0[2], silu_(g0[3]) * u0[3]);
                w.z = cvt_pk_bf16(silu_(g1[0]) * u1[0], silu_(g1[1]) * u1[1]); w.w = cvt_pk_bf16(silu_(g1[2]) * u1[2], silu_(g1[3]) * u1[3]);
                *(GAS u32x4*)(ACT + (size_t)(row0 + ai * 128 + m * 16) * 512 + ch0) = w; }
    }
};
struct EpiDown {
    static constexpr bool PERM = true;
    bf16_t* CT; const float* roww; const LAS int* tpre;
    __device__ __forceinline__ void operator()(const f32x4 (&acc)[2][2][4][2], const pg8::Unit& u, int wr, int wc, int fr, int fq) const {
        const int lr0 = wr * 64 + fr, col0 = u.pn * 256 + wc * 32 + 8 * fq; const int pos0 = (u.pm - tpre[u.e]) * 256;
#pragma unroll
        for (int ai = 0; ai < 2; ++ai)
#pragma unroll
            for (int m = 0; m < 4; ++m) { const int lr = lr0 + ai * 128 + m * 16; const float wt = lr < u.nvalid ? roww[(size_t)u.e * ECAP + pos0 + lr] : 0.f;
#pragma unroll
                for (int bj = 0; bj < 2; ++bj) { const f32x4 v0 = acc[ai][bj][m][0] * wt, v1 = acc[ai][bj][m][1] * wt;
                    u32x4 w; w.x = cvt_pk_bf16(v0[0], v0[1]); w.y = cvt_pk_bf16(v0[2], v0[3]); w.z = cvt_pk_bf16(v1[0], v1[1]); w.w = cvt_pk_bf16(v1[2], v1[3]);
                    *(GAS u32x4*)(CT + (size_t)(u.pm * 256 + lr) * 1024 + col0 + bj * 128) = w; } }
    }
};

__device__ __forceinline__ void p12_final(Frame& F, const Args& a) {
    LAS int* tpre = (LAS int*)(F.lds + 0); LAS int* cnts = tpre + 64;
    moe_setup(F, tpre, cnts);
    LAS float* g2 = (LAS float*)(F.lds + 1024);
    LAS float* fg = g2 + 2 * D;
    const float* modv = (const float*)(F.ws + WS_MODV);
    *(LAS f32x4*)(g2 + 4 * F.tid) = *(const GAS f32x4*)(modv + 10 * D + 4 * F.tid);
    if (F.tid < D / 4) *(LAS f32x4*)(fg + 4 * F.tid) = *(const GAS f32x4*)(a.final_g + 4 * F.tid);
    __syncthreads();
    const int* tok_e = (const int*)(F.ws + WS_TOKE); const int* tok_p = (const int*)(F.ws + WS_TOKP); const bf16_t* CT = (const bf16_t*)(F.ws + WS_CONTRIB);
    const int gw = F.vcu * NWAVES + F.wave, NGW = F.G * NWAVES, lane = F.lane;
    for (int m = gw; m < T; m += 2 * NGW) {
        int mm[2]; mm[0] = m; mm[1] = (m + NGW < T) ? m + NGW : m;
        size_t r0[2], r1[2];
#pragma unroll
        for (int q = 0; q < 2; ++q) { const int e0 = tok_e[mm[q] * 2], e1 = tok_e[mm[q] * 2 + 1]; r0[q] = (size_t)(tpre[e0] * 256 + tok_p[mm[q] * 2]); r1[q] = (size_t)(tpre[e1] * 256 + tok_p[mm[q] * 2 + 1]); }
        f32x4 xv[2][4]; u32x2 pv[2][4], qv[2][4];
#pragma unroll
        for (int q = 0; q < 2; ++q) { const GAS f32x4* xr = (const GAS f32x4*)(a.out + (size_t)mm[q] * D) + lane;
            const GAS u32x2* c0 = (const GAS u32x2*)(CT + r0[q] * 1024) + lane; const GAS u32x2* c1 = (const GAS u32x2*)(CT + r1[q] * 1024) + lane;
#pragma unroll
            for (int j = 0; j < 4; ++j) { xv[q][j] = xr[64 * j]; pv[q][j] = c0[64 * j]; qv[q][j] = c1[64 * j]; } }
        f32x4 v[2][4]; float sv[2] = {0.f, 0.f};
#pragma unroll
        for (int q = 0; q < 2; ++q) { const int b = mm[q] / SEQ;
#pragma unroll
            for (int j = 0; j < 4; ++j) { const u32x2 p = pv[q][j], qq = qv[q][j]; const f32x4 g = *(const LAS f32x4*)(g2 + b * D + 256 * j + 4 * lane);
                f32x4 y; y.x = bf_lo(p.x) + bf_lo(qq.x); y.y = bf_hi(p.x) + bf_hi(qq.x); y.z = bf_lo(p.y) + bf_lo(qq.y); y.w = bf_hi(p.y) + bf_hi(qq.y);
                v[q][j] = xv[q][j] + g * y; sv[q] += (v[q][j].x * v[q][j].x + v[q][j].y * v[q][j].y) + (v[q][j].z * v[q][j].z + v[q][j].w * v[q][j].w); } }
#pragma unroll
        for (int o = 1; o < 64; o <<= 1) { sv[0] += __shfl_xor(sv[0], o); sv[1] += __shfl_xor(sv[1], o); }
#pragma unroll
        for (int q = 0; q < 2; ++q) if (q == 0 || mm[1] != mm[0]) { const float rstd = 1.f / sqrtf(sv[q] * (1.f / D) + NORM_EPS);
            GAS f32x4* orow = (GAS f32x4*)(a.out + (size_t)mm[q] * D) + lane;
#pragma unroll
            for (int j = 0; j < 4; ++j) orow[64 * j] = v[q][j] * rstd * *(const LAS f32x4*)(fg + 256 * j + 4 * lane); }
    }
}

__global__ void __launch_bounds__(NTHR, 2) mk_fwd(Args args) {
    extern __shared__ __attribute__((aligned(16))) unsigned char lds_raw[];
    Frame F;
    F.lds = (LAS unsigned char*)lds_raw; F.MISC = (volatile LAS unsigned*)(F.lds + MISC_OFF);
    F.tid = threadIdx.x; F.lane = F.tid & 63; F.wave = __builtin_amdgcn_readfirstlane(F.tid >> 6);
    F.G = gridDim.x; { const int bx = blockIdx.x; F.vcu = (F.G % 8 == 0) ? (bx % 8) * (F.G / 8) + bx / 8 : bx; }
    F.ws = args.ws; F.ctl = (unsigned*)(args.ws + WS_CTL);
    if (F.tid < 64) F.MISC[F.tid] = 0u;
    __syncthreads();
    XcdBarrier bar; bar.bar = F.ctl + CW_BAR; bar.x = 0; bar.st = nullptr;
    if (N_LAUNCHES == 1) bar = xcd_barrier_post(F.ctl + CW_BAR, F.MISC + 8);
    const int lo = args.ph_lo, hi = args.ph_hi;
#define IN(k) (lo <= (k) && (k) < hi)
#define SEAM(k) do { if (IN(k) && IN((k) + 1)) xcd_barrier(bar); } while (0)
    unsigned char* ws = args.ws;

#ifndef PROBE_PH
#define PROBE_PH (-1)
#endif
#define REPS(k) for (int rep_ = 0; rep_ < ((PROBE_PH) == (k) ? 2 : 1); ++rep_)
#define REPBAR(k) do { if ((PROBE_PH) == (k) && rep_ == 0) xcd_barrier(bar); } while (0)
    if (IN(0)) REPS(0) { p0_prologue(F, args); REPBAR(0); } SEAM(0);
    if (IN(1)) { p1_finalize(F, args); } SEAM(1);
    if (IN(2)) REPS(2) { p2_h1_rows(F, args); REPBAR(2); } SEAM(2);
    if (IN(3)) {
        pg8::StaticOrder S; S.init(ws + WS_R1, ws + WS_WIN, T, DIN, D, F.G, (int)blockIdx.x);
        EpiInProj E{(bf16_t*)(ws + WS_Q), (bf16_t*)(ws + WS_K), (bf16_t*)(ws + WS_V), (bf16_t*)(ws + WS_U), (bf16_t*)(ws + WS_BG), (bf16_t*)args.out, (bf16_t*)args.out + (size_t)T * D, args.b_gate};
        pg8::gemm_phase<EpiInProj, pg8::StaticOrder, true, false>(F.lds, D, S, E);
    } SEAM(3);
    if (IN(4)) REPS(4) { p3_kmean(F); REPBAR(4); } SEAM(4);
    if (IN(5)) { p4_topk(F); } SEAM(5);
    if (IN(6)) REPS(6) { p5_attention(F, args); REPBAR(6); } SEAM(6);
    if (IN(7)) REPS(7) { p6_combine_conv(F, args); REPBAR(7); } SEAM(7);
    if (IN(8)) {
        { pg8::StaticOrder S; S.init(ws + WS_R1, ws + WS_WAO, T, D, AW, F.G, (int)blockIdx.x);
          EpiGate<false> E{(bf16_t*)(ws + WS_MERGED), (const bf16_t*)args.out};
          pg8::gemm_phase<EpiGate<false>, pg8::StaticOrder, false, false>(F.lds, AW, S, E); }
        VM_WAIT(); __syncthreads();
        { pg8::StaticOrder S; S.init(ws + WS_R1 + (size_t)T * 512 * 2, ws + WS_WCO, T, D, CWD, F.G, (int)blockIdx.x);
          EpiGate<true> E{(bf16_t*)(ws + WS_MERGED), (const bf16_t*)args.out + (size_t)T * D};
          pg8::gemm_phase<EpiGate<true>, pg8::StaticOrder, false, false>(F.lds, CWD, S, E); }
    } SEAM(8);
    if (IN(9)) {
        pg8::StaticOrder S; S.init(ws + WS_MERGED, ws + WS_WO, T, D, D, F.G, (int)blockIdx.x);
        EpiResid E{args.x, args.out, (const float*)(ws + WS_MODV) + 4 * D};
        pg8::gemm_phase<EpiResid, pg8::StaticOrder, false, false>(F.lds, D, S, E);
    } SEAM(9);
    if (IN(10)) { p9_norm_route(F, args); } SEAM(10);
    if (IN(11)) {
        LAS int* tpre = (LAS int*)(F.lds + MISC_OFF + 256); LAS int* cnts = tpre + 64; LAS int* rowtab = (LAS int*)(F.lds + ROWTAB_OFF);
        const int ntiles = moe_setup(F, tpre, cnts);
        MoeOrder S{tpre, cnts, rowtab, (const char*)(ws + WS_R1), (const char*)(ws + WS_WGU), 0, (size_t)1024 * 1024 * 2, (size_t)256 * 1024 * 2, F.G, (int)blockIdx.x, ntiles * 4};
        { pg8::Unit u; const int* rowidx = (const int*)(ws + WS_ROWIDX);
          for (int i = 0; i < 8 && S.next(i, u); ++i) { if (F.tid < 256) { const int r0 = (u.pm - tpre[u.e]) * 256; rowtab[i * 256 + F.tid] = F.tid < u.nvalid ? rowidx[(size_t)u.e * ECAP + r0 + F.tid] : rowidx[(size_t)u.e * ECAP + r0]; } } }
        __syncthreads();
        EpiSwiglu E{(bf16_t*)(ws + WS_ACT)};
        pg8::gemm_phase<EpiSwiglu, MoeOrder, true, true>(F.lds, D, S, E);
    } SEAM(11);
    if (IN(12)) {
        LAS int* tpre = (LAS int*)(F.lds + MISC_OFF + 256); LAS int* cnts = tpre + 64;
        const int ntiles = moe_setup(F, tpre, cnts);
        MoeOrder S{tpre, cnts, nullptr, (const char*)(ws + WS_ACT), (const char*)(ws + WS_WD), (size_t)256 * 512 * 2, (size_t)1024 * 512 * 2, (size_t)256 * 512 * 2, F.G, (int)blockIdx.x, ntiles * 4};
        EpiDown E{(bf16_t*)(ws + WS_CONTRIB), (const float*)(ws + WS_ROWW), tpre};
        pg8::gemm_phase<EpiDown, MoeOrder, true, false>(F.lds, DE, S, E);
    } SEAM(12);
    if (IN(13)) { p12_final(F, args); }
#undef REPS
#undef REPBAR
#undef IN
#undef SEAM
}

extern "C" void kernel_launch(void* const* d_in, const int* in_sizes, int n_in, void* d_out, int out_size, void* d_ws, size_t ws_size, hipStream_t stream) {
    static int grid = 0;
    if (grid == 0) {
        if (n_in != 21 || in_sizes[0] != T * D || out_size != T * D || ws_size < WS_END) { fprintf(stderr, "kernel_launch: unexpected shapes (n_in %d, in0 %d, out %d, ws %zu < %zu)\n", n_in, n_in > 0 ? in_sizes[0] : -1, out_size, ws_size, (size_t)WS_END); grid = -1; return; }
        int dev = 0, cus = 0, per_cu = 0;
        if (hipGetDevice(&dev) != hipSuccess || hipDeviceGetAttribute(&cus, hipDeviceAttributeMultiprocessorCount, dev) != hipSuccess) { grid = -1; return; }
        if (hipFuncSetAttribute((const void*)mk_fwd, hipFuncAttributeMaxDynamicSharedMemorySize, LDS_BYTES) != hipSuccess) { fprintf(stderr, "kernel_launch: hipFuncSetAttribute failed\n"); grid = -1; return; }
        if (hipOccupancyMaxActiveBlocksPerMultiprocessor(&per_cu, (const void*)mk_fwd, NTHR, LDS_BYTES) != hipSuccess || per_cu < 1) fprintf(stderr, "kernel_launch: occupancy query reports %d\n", per_cu);
        (void)hipGetLastError();
        grid = cus;
    }
    if (grid < 0) return;
    if (hipMemsetAsync((char*)d_ws + WS_CTL, 0, CTL_ZERO_BYTES, stream) != hipSuccess) return;
    Args a{};
    const float** ap = (const float**)&a;
    for (int i = 0; i < 21; ++i) ap[i] = (const float*)d_in[i];
    a.out = (float*)d_out; a.ws = (unsigned char*)d_ws;
    for (int li = 0; li < N_LAUNCHES; ++li) {
        a.ph_lo = (N_LAUNCHES == 1) ? 0 : li; a.ph_hi = (N_LAUNCHES == 1) ? N_PHASES : li + 1;
        hipLaunchKernelGGL(mk_fwd, dim3(grid), dim3(NTHR), LDS_BYTES, stream, a);
        if (hipPeekAtLastError() != hipSuccess) { fprintf(stderr, "kernel_launch: launch %d failed\n", li); break; }
    }
}
```

```cpp
#include <hip/hip_runtime.h>
#include <cstdio>
#include <cstdint>
#define PROBE_PH (-1)

#define LAS __attribute__((address_space(3)))
#define GAS __attribute__((address_space(1)))
typedef unsigned short bf16_t;
typedef short bf16x8 __attribute__((ext_vector_type(8)));
typedef short s16x4 __attribute__((ext_vector_type(4)));
typedef float f32x4 __attribute__((ext_vector_type(4)));
typedef float f32x16 __attribute__((ext_vector_type(16)));
typedef float f32x2 __attribute__((ext_vector_type(2)));
typedef unsigned u32x4 __attribute__((ext_vector_type(4)));
typedef unsigned u32x2 __attribute__((ext_vector_type(2)));
typedef __bf16 bf16x2_t __attribute__((ext_vector_type(2)));

__device__ __forceinline__ unsigned cvt_pk_bf16(float lo, float hi) { f32x2 v = {lo, hi}; bf16x2_t b = __builtin_convertvector(v, bf16x2_t); return __builtin_bit_cast(unsigned, b); }
__device__ __forceinline__ float bf_lo(unsigned u) { return __builtin_bit_cast(float, u << 16); }
__device__ __forceinline__ float bf_hi(unsigned u) { return __builtin_bit_cast(float, u & 0xffff0000u); }
__device__ __forceinline__ float sigmoidf_(float x) { return __builtin_amdgcn_rcpf(1.f + __expf(-x)); }

namespace pg8 {
constexpr int BM = 256, BK = 64, HALF = 128, HTB = HALF * BK * 2, STAGE_BYTES = 8 * HTB, NXCD = 8, WGM = 8;
__host__ __device__ __forceinline__ int lds_byte(int r, int c) { const int st = (r >> 4) * 2 + (c >> 5), rr = r & 15, cc = c & 31, ob = rr * 64 + cc * 2; return st * 1024 + (ob ^ (((ob >> 9) & 1) << 5)); }
__host__ __device__ __forceinline__ void stage_rc(int b, int& R, int& C) { const int st = b / 1024, sb = b % 1024, swz = sb ^ (((sb >> 9) & 1) << 5); R = (st >> 1) * 16 + swz / 64; C = (st & 1) * 32 + (swz % 64) / 2; }
__host__ __device__ __forceinline__ int perm32(int rho) { const int n = rho >> 4, i = rho & 15; return 8 * (i >> 2) + 4 * n + (i & 3); }

struct Unit { const char* A; const char* B; int pm, pn, e, nvalid; };

struct StaticOrder {
    const char* A; const char* Bt; int K; int nM, nN, nwg, G, c;
    __device__ void init(const void* A_, const void* Bt_, int M, int N, int K_, int G_, int c_) { A = (const char*)A_; Bt = (const char*)Bt_; K = K_; nM = M / BM; nN = N / BM; nwg = nM * nN; G = G_; c = c_; }
    __device__ bool next(int i, Unit& u) const {
        const long L = (long)i * G + c; if (L >= nwg) return false;
        int wgid = (int)L; { const int q = nwg / NXCD, r = nwg % NXCD, xcd = wgid % NXCD, off = wgid / NXCD; wgid = (xcd < r ? xcd * (q + 1) : r * (q + 1) + (xcd - r) * q) + off; }
        const int nig = WGM * nN, gid = wgid / nig, fm = gid * WGM, gsz = (nM - fm) < WGM ? (nM - fm) : WGM;
        u.pm = fm + ((wgid % nig) % gsz); u.pn = (wgid % nig) / gsz; u.e = 0; u.nvalid = 256;
        u.A = A + (size_t)u.pm * 256 * K * 2; u.B = Bt + (size_t)u.pn * 256 * K * 2; return true;
    }
    __device__ __forceinline__ unsigned arow(int, int) const { return 0u; }
};

template <class Epi, class Sched, bool ALIGN_EPI, bool GATHER>
__device__ __forceinline__ void gemm_phase(LAS unsigned char* lds, const int K, const Sched& S, const Epi& E) {
    const int tid = threadIdx.x, wid = __builtin_amdgcn_readfirstlane(tid >> 6), lane = tid & 63, wr = wid >> 2, wc = wid & 3, fr = lane & 15, fq = lane >> 4;
    const int nt = K / BK;
    unsigned voffB[2]; int RA[2], CA[2];
#pragma unroll
    for (int i = 0; i < 2; ++i) { int R, C; stage_rc(tid * 16 + i * 8192, R, C); const int Rb = Epi::PERM ? ((R & ~31) + perm32(R & 31)) : R;
        RA[i] = R; CA[i] = C; voffB[i] = (unsigned)(Rb * K + C) * 2u; }
    const size_t kstep = (size_t)(BK * 2);
    const size_t hstep = (size_t)HALF * K * 2;
    const unsigned ldsw = (unsigned)wid * 1024u;
    const int aoff = lds_byte(wr * 64 + fr, fq * 8), boff = lds_byte(wc * 32 + fr, fq * 8);
#define PG8_SA(b, h) (((b) * 2 + (h)) * HTB)
#define PG8_SB(b, h) ((4 + (b) * 2 + (h)) * HTB)
#define PG8_STAGE(bufoff, gbase, voff) do { _Pragma("unroll") for (int _i = 0; _i < 2; ++_i) \
        __builtin_amdgcn_global_load_lds((const unsigned*)((const char*)(gbase) + (voff)[_i]), (LAS unsigned*)(lds + (bufoff) + ldsw + _i * 8192), 16, 0, 0); } while (0)
#define PG8_LDA(dst, b, h) do { _Pragma("unroll") for (int m = 0; m < 4; ++m) _Pragma("unroll") for (int k = 0; k < 2; ++k) dst[m][k] = *(const LAS bf16x8*)(lds + PG8_SA(b, h) + aoff + m * 2048 + k * 1024); } while (0)
#define PG8_LDB(dst, b, h) do { _Pragma("unroll") for (int n = 0; n < 2; ++n) _Pragma("unroll") for (int k = 0; k < 2; ++k) dst[n][k] = *(const LAS bf16x8*)(lds + PG8_SB(b, h) + boff + n * 2048 + k * 1024); } while (0)
#define PG8_MMA(ai, bj, At, Bt) do { __builtin_amdgcn_s_setprio(1); _Pragma("unroll") for (int m = 0; m < 4; ++m) _Pragma("unroll") for (int n = 0; n < 2; ++n) _Pragma("unroll") for (int k = 0; k < 2; ++k) \
        acc[ai][bj][m][n] = __builtin_amdgcn_mfma_f32_16x16x32_bf16(Bt[n][k], At[m][k], acc[ai][bj][m][n], 0, 0, 0); __builtin_amdgcn_s_setprio(0); } while (0)
#define PG8_WAIT_V(n) asm volatile("s_waitcnt vmcnt(" #n ")" ::: "memory")
#define PG8_WAIT_L(n) asm volatile("s_waitcnt lgkmcnt(" #n ")" ::: "memory")
#define PG8_BAR __builtin_amdgcn_s_barrier()
#define PG8_SCHED __builtin_amdgcn_sched_barrier(0)
    Unit cur, nxt; int ui = 0;
    if (!S.next(0, cur)) return;
    f32x4 acc[2][2][4][2];
#pragma unroll
    for (int a = 0; a < 2; ++a)
#pragma unroll
        for (int b = 0; b < 2; ++b)
#pragma unroll
            for (int m = 0; m < 4; ++m)
#pragma unroll
                for (int n = 0; n < 2; ++n) acc[a][b][m][n] = (f32x4){0.f, 0.f, 0.f, 0.f};
    bf16x8 At[4][2], B0[2][2], B1[2][2];
    unsigned va[2][2], vn[2][2];
#pragma unroll
    for (int h = 0; h < 2; ++h)
#pragma unroll
        for (int i = 0; i < 2; ++i) {
            if constexpr (GATHER) va[h][i] = S.arow(0, h * HALF + RA[i]) * (unsigned)(K * 2) + (unsigned)(CA[i] * 2);
            else va[h][i] = (unsigned)((h * HALF + RA[i]) * K + CA[i]) * 2u;
            vn[h][i] = va[h][i]; }
    const char* cA = cur.A; const char* cB = cur.B;
    PG8_STAGE(PG8_SB(0, 0), cB, voffB); PG8_STAGE(PG8_SB(0, 1), cB + hstep, voffB); PG8_STAGE(PG8_SA(0, 0), cA, va[0]); PG8_STAGE(PG8_SA(0, 1), cA, va[1]);
    if (wr == 1) PG8_BAR;
    PG8_WAIT_V(2); PG8_BAR;
    PG8_STAGE(PG8_SB(1, 0), cB + kstep, voffB); PG8_STAGE(PG8_SA(1, 0), cA + kstep, va[0]); PG8_STAGE(PG8_SB(1, 1), cB + hstep + kstep, voffB);
    PG8_WAIT_V(6); PG8_BAR;
    for (;;) {
        const bool has_next = S.next(ui + 1, nxt);
        const char* nA = has_next ? nxt.A : cA; const char* nB = has_next ? nxt.B : cB;
        if constexpr (GATHER) { if (has_next) {
#pragma unroll
            for (int h = 0; h < 2; ++h)
#pragma unroll
                for (int i = 0; i < 2; ++i) vn[h][i] = S.arow(ui + 1, h * HALF + RA[i]) * (unsigned)(K * 2) + (unsigned)(CA[i] * 2); } }
        for (int t = 0; t < nt; t += 2) {
            const bool last = (t == nt - 2);
            const char* a1 = cA + (size_t)(t + 1) * kstep;
            const char* a2 = last ? nA : cA + (size_t)(t + 2) * kstep; const char* b2 = last ? nB : cB + (size_t)(t + 2) * kstep;
            const char* a3 = a2 + kstep; const char* b3 = b2 + kstep;
            unsigned w0[2], w1[2];
            if constexpr (GATHER) { w0[0] = last ? vn[0][0] : va[0][0]; w0[1] = last ? vn[0][1] : va[0][1]; w1[0] = last ? vn[1][0] : va[1][0]; w1[1] = last ? vn[1][1] : va[1][1]; }
            else { w0[0] = va[0][0]; w0[1] = va[0][1]; w1[0] = va[1][0]; w1[1] = va[1][1]; }
            PG8_LDB(B0, 0, 0); PG8_LDB(B1, 0, 1); PG8_SCHED; PG8_LDA(At, 0, 0); PG8_STAGE(PG8_SA(1, 1), a1, va[1]);
            PG8_WAIT_V(8); PG8_WAIT_L(0); PG8_BAR; PG8_MMA(0, 0, At, B0); PG8_MMA(0, 1, At, B1); PG8_BAR; PG8_SCHED;
            PG8_LDA(At, 0, 1); PG8_STAGE(PG8_SB(0, 0), b2, voffB); PG8_STAGE(PG8_SB(0, 1), b2 + hstep, voffB); PG8_STAGE(PG8_SA(0, 0), a2, w0);
            PG8_WAIT_V(8); PG8_WAIT_L(0); PG8_BAR; PG8_MMA(1, 0, At, B0); PG8_MMA(1, 1, At, B1); PG8_BAR; PG8_SCHED;
            PG8_LDB(B0, 1, 0); PG8_LDB(B1, 1, 1); PG8_SCHED; PG8_LDA(At, 1, 0); PG8_STAGE(PG8_SA(0, 1), a2, w1);
            PG8_WAIT_V(8); PG8_WAIT_L(0); PG8_BAR; PG8_MMA(0, 0, At, B0); PG8_MMA(0, 1, At, B1); PG8_BAR; PG8_SCHED;
            PG8_LDA(At, 1, 1); PG8_STAGE(PG8_SB(1, 0), b3, voffB); PG8_STAGE(PG8_SB(1, 1), b3 + hstep, voffB); PG8_STAGE(PG8_SA(1, 0), a3, w0);
            PG8_WAIT_V(8); PG8_WAIT_L(0); PG8_BAR; PG8_MMA(1, 0, At, B0); PG8_MMA(1, 1, At, B1); PG8_BAR; PG8_SCHED;
        }
        if constexpr (ALIGN_EPI) { if (wr == 0) PG8_BAR; }
        E(acc, cur, wr, wc, fr, fq);
        if (!has_next) break;
#pragma unroll
        for (int a = 0; a < 2; ++a)
#pragma unroll
            for (int b = 0; b < 2; ++b)
#pragma unroll
                for (int m = 0; m < 4; ++m)
#pragma unroll
                    for (int n = 0; n < 2; ++n) acc[a][b][m][n] = (f32x4){0.f, 0.f, 0.f, 0.f};
        cur = nxt; cA = nA; cB = nB; ++ui;
#pragma unroll
        for (int h = 0; h < 2; ++h)
#pragma unroll
            for (int i = 0; i < 2; ++i) va[h][i] = vn[h][i];
        if constexpr (ALIGN_EPI) { if (wr == 1) PG8_BAR; }
    }
    PG8_WAIT_V(0);
    if constexpr (!ALIGN_EPI) { if (wr == 0) PG8_BAR; }
    PG8_BAR;
#undef PG8_SA
#undef PG8_SB
#undef PG8_STAGE
#undef PG8_LDA
#undef PG8_LDB
#undef PG8_MMA
#undef PG8_WAIT_V
#undef PG8_WAIT_L
#undef PG8_BAR
#undef PG8_SCHED
}
}

constexpr int NWAVES = 8, NTHR = 512;
constexpr int BATCH = 2, SEQ = 8192, D = 1024, T = BATCH * SEQ;
constexpr int NH = 8, HD = 64, AW = 512, CWD = 512, DIN = 5120, MB = 256, NBLK = SEQ / MB  , TOPK = 3;
constexpr int NE = 32, NGRP = 4, EPG = 8, DE = 512, NMOD = 6;
constexpr float NORM_EPS = 1e-6f;
constexpr float LOG2E = 1.4426950408889634f;
constexpr float QSCALE = 0.125f * LOG2E;
constexpr int CAPQ = (NBLK - 1) * MB;
constexpr int ECAP = T;
constexpr int APAD_MAX = 2 * T + NE * 255;
constexpr int MOD_KS = 16;

#ifndef MK_N_LAUNCHES
#define MK_N_LAUNCHES 1
#endif
constexpr int N_PHASES = 14;
constexpr int N_LAUNCHES = MK_N_LAUNCHES;

constexpr size_t MiB = 1u << 20;
constexpr size_t WS_CTL = 0, CTL_ZERO_BYTES = 65536;
constexpr size_t WS_MODPART = 1 * MiB;
constexpr size_t WS_MODV = 2 * MiB;
constexpr size_t WS_WRT = 2 * MiB + 768 * 1024;
constexpr size_t WS_KMEAN = 2 * MiB + 256 * 1024;
constexpr size_t WS_KMAX = 2 * MiB + 384 * 1024;
constexpr size_t WS_QN = 24 * MiB + 512 * 1024;
constexpr size_t WS_TOKE = 2 * MiB + 512 * 1024;
constexpr size_t WS_TOKP = WS_TOKE + 128 * 1024;
constexpr size_t WS_ROWIDX = 3 * MiB;
constexpr size_t WS_ROWW = 5 * MiB;
constexpr size_t WS_ML = 7 * MiB;
constexpr size_t WS_LIST = 9 * MiB;
constexpr size_t WS_WIN = 25 * MiB, WS_WAO = 35 * MiB, WS_WCO = 36 * MiB, WS_WO = 37 * MiB;
constexpr size_t WS_OPART = 39 * MiB;
constexpr size_t WS_WGU = 39 * MiB, WS_WD = 103 * MiB;
constexpr size_t WS_R1 = 135 * MiB;
constexpr size_t WS_Q = 167 * MiB, WS_K = 183 * MiB, WS_V = 199 * MiB;
constexpr size_t WS_MERGED = 167 * MiB;
constexpr size_t WS_U = 215 * MiB, WS_BG = 231 * MiB;
constexpr size_t WS_CONTRIB = 167 * MiB;
constexpr size_t WS_ACT = 247 * MiB;
constexpr size_t WS_END = 287 * MiB;
static_assert(WS_CONTRIB + (size_t)APAD_MAX * 1024 * 2 <= WS_ACT && WS_ACT + (size_t)APAD_MAX * 512 * 2 <= WS_END, "ws map");
static_assert(WS_LIST + (size_t)512 * CAPQ * 4 <= WS_WIN, "ws map lists");
constexpr int CW_TMO = 0;
constexpr int CW_BAR = 4096;
constexpr int CW_QCNT = 8192;
constexpr int CW_ECNT = 9216;
constexpr int RING_BYTES = 131072;
constexpr int ROWTAB_OFF = 131072;
constexpr int LDS_BYTES = 163840;
constexpr int MISC_OFF = LDS_BYTES - 1024;

#define LDS_WAIT() asm volatile("s_waitcnt lgkmcnt(0)" ::: "memory")
#define VM_WAIT() asm volatile("s_waitcnt vmcnt(0)" ::: "memory")

#define XB_TMO      128
#define XB_XCNT(j)  (256  + 64 * (j))
#define XB_XSUB(j)  (1280 + 64 * (j))
#define XB_XGEN(j)  (2304 + 64 * (j))
#define XB_TOP      3328
#define XB_TOPGEN   3392
#define XCD_BAR_WORDS 3456
#define XB_SPIN_CAP (1u << 18)
__device__ __forceinline__ unsigned xb_ld(unsigned* p)              { return __hip_atomic_load(p, __ATOMIC_RELAXED, __HIP_MEMORY_SCOPE_AGENT); }
__device__ __forceinline__ unsigned xb_add(unsigned* p, unsigned v) { return __hip_atomic_fetch_add(p, v, __ATOMIC_RELAXED, __HIP_MEMORY_SCOPE_AGENT); }
__device__ __forceinline__ unsigned xb_xcc_id() { return (unsigned)__builtin_amdgcn_s_getreg((3 << 11) | 20) & 0xFu; }
#define XB_SPIN(cond, bar) do { unsigned _sp = 0; while (cond) { __builtin_amdgcn_s_sleep(1); \
    if ((++_sp & 255u) == 0u) { if (xb_ld(&(bar)[XB_TMO])) break; if (_sp > XB_SPIN_CAP) { atomicAdd(&(bar)[XB_TMO], 1u); break; } } } } while (0)
struct XcdBarrier { unsigned* bar; unsigned x; volatile LAS unsigned* st; };
__device__ __forceinline__ XcdBarrier xcd_barrier_post(unsigned* bar, volatile LAS unsigned* st) {
    XcdBarrier b; b.bar = bar; b.x = xb_xcc_id(); b.st = st;
    if (threadIdx.x == 0) (void)xb_add(&bar[XB_XCNT(b.x)], 1u);
    return b;
}
__device__ __forceinline__ void xcd_barrier_complete(unsigned* bar, unsigned x, unsigned& nloc, unsigned& nx) {
    const unsigned G = gridDim.x * gridDim.y * gridDim.z;
    unsigned sum, cnt, mine, sp = 0u;
    for (;;) {
        sum = 0u; cnt = 0u; mine = 0u;
#pragma unroll
        for (unsigned j = 0; j < 16; ++j) { const unsigned c = xb_ld(&bar[XB_XCNT(j)]); sum += c; cnt += (c > 0u) ? 1u : 0u; mine = (j == x) ? c : mine; }
        if (sum == G) break;
        __builtin_amdgcn_s_sleep(1);
        if ((++sp & 255u) == 0u) { if (xb_ld(&bar[XB_TMO])) break; if (sp > XB_SPIN_CAP) { atomicAdd(&bar[XB_TMO], 1u); break; } }
    }
    nloc = mine > 0u ? mine : 1u; nx = cnt > 0u ? cnt : 1u;
}
__device__ __forceinline__ void xcd_barrier(const XcdBarrier& b) {
    asm volatile("s_waitcnt vmcnt(0)" ::: "memory");
    __syncthreads();
    if (threadIdx.x == 0) {
        unsigned* bar = b.bar;
        __builtin_amdgcn_s_waitcnt(0);
        unsigned nloc = b.st[0], nx = b.st[1];
        if (nloc == 0u) { xcd_barrier_complete(bar, b.x, nloc, nx); b.st[0] = nloc; b.st[1] = nx; }
        const unsigned old = xb_add(&bar[XB_XSUB(b.x)], 1u);
        const unsigned gen = old / nloc;
        if (old + 1u == (gen + 1u) * nloc) {
            __builtin_amdgcn_fence(__ATOMIC_RELEASE, "agent");
            asm volatile("s_waitcnt vmcnt(0)" ::: "memory");
            const unsigned og = xb_add(&bar[XB_TOP], 1u);
            const unsigned tg = og / nx;
            if (og + 1u == (tg + 1u) * nx) xb_add(&bar[XB_TOPGEN], 1u);
            else XB_SPIN(xb_ld(&bar[XB_TOPGEN]) == tg, bar);
            __builtin_amdgcn_fence(__ATOMIC_ACQUIRE, "agent");
            xb_add(&bar[XB_XGEN(b.x)], 1u);
            asm volatile("s_waitcnt vmcnt(0)" ::: "memory");
        } else {
            XB_SPIN(xb_ld(&bar[XB_XGEN(b.x)]) == gen, bar);
            __builtin_amdgcn_fence(__ATOMIC_ACQUIRE, "agent");
            asm volatile("s_waitcnt vmcnt(0)" ::: "memory");
        }
    }
    __syncthreads();
}

struct Args {
    const float *x, *c, *rel_bias, *norm1_g, *norm2_g, *w_ada, *b_ada, *w_in, *b_gate, *conv_w, *w_attn_out, *w_conv_out, *w_o,
                *w_rg, *b_rg, *w_re, *b_re, *w_eg, *w_eu, *w_ed, *final_g;
    float* out; unsigned char* ws; int ph_lo, ph_hi;
};
struct Frame {
    LAS unsigned char* lds; volatile LAS unsigned* MISC; unsigned* ctl; unsigned char* ws;
    int tid, lane, wave, G, vcu;
};
__device__ __forceinline__ float wave_sum(float v) {
#pragma unroll
    for (int o = 1; o < 64; o <<= 1) v += __shfl_xor(v, o);
    return v;
}
__device__ __forceinline__ float silu_(float v) { return v * sigmoidf_(v); }

__device__ __forceinline__ void transpose_item(const float* W, int K, int N, bf16_t* WT, int k0, int n0, int drow0, LAS float* scr, int lane) {
#pragma unroll 8
    for (int i = 0; i < 32; ++i) { const int kk = 2 * i + (lane >> 5); scr[kk * 33 + (lane & 31)] = W[(size_t)(k0 + kk) * N + n0 + (lane & 31)]; }
    LDS_WAIT(); asm volatile("" ::: "memory");
    const int c = lane & 7;
#pragma unroll
    for (int j = 0; j < 4; ++j) { const int n = (lane >> 3) + 8 * j; const LAS float* s = scr + (8 * c) * 33 + n;
        u32x4 o; o.x = cvt_pk_bf16(s[0 * 33], s[1 * 33]); o.y = cvt_pk_bf16(s[2 * 33], s[3 * 33]); o.z = cvt_pk_bf16(s[4 * 33], s[5 * 33]); o.w = cvt_pk_bf16(s[6 * 33], s[7 * 33]);
        *(GAS u32x4*)(WT + (size_t)(drow0 + n) * K + k0 + 8 * c) = o; }
    LDS_WAIT(); asm volatile("" ::: "memory");
}

__device__ __forceinline__ int win_dest_row(int n0) {
    if (n0 < 1536) return n0;
    if (n0 < 2048) { const int ch = n0 - 1536; return 256 * (6 + (ch >> 7)) + (ch & 127); }
    if (n0 < 2560) return 2560 + (n0 - 2048);
    if (n0 < 3072) { const int ch = n0 - 2560; return 256 * (6 + (ch >> 7)) + 128 + (ch & 127); }
    return n0;
}
__device__ __forceinline__ void p0_prologue(Frame& F, const Args& a) {
    LAS float* cact = (LAS float*)F.lds;
    for (int i = F.tid; i < 2 * D; i += NTHR) cact[i] = silu_(a.c[i]);
    __syncthreads();
    float* modpart = (float*)(F.ws + WS_MODPART);
    const int gw = F.vcu * NWAVES + F.wave, NGW = F.G * NWAVES, lane = F.lane;
    constexpr int NCG = (NMOD * D) / 64, KSL = D / MOD_KS;
    for (int it = gw; it < NCG * MOD_KS; it += NGW) {
        const int cg = it % NCG, ks = it / NCG, col = cg * 64 + (lane & 15) * 4, kr = lane >> 4;
        f32x4 a0 = {0.f, 0.f, 0.f, 0.f}, a1 = {0.f, 0.f, 0.f, 0.f};
#pragma unroll
        for (int i = 0; i < KSL / 4; ++i) { const int k = ks * KSL + 4 * i + kr; const f32x4 w = *(const GAS f32x4*)(a.w_ada + (size_t)k * (NMOD * D) + col); a0 += w * cact[k]; a1 += w * cact[D + k]; }
#pragma unroll
        for (int c = 0; c < 4; ++c) { a0[c] += __shfl_xor(a0[c], 16); a0[c] += __shfl_xor(a0[c], 32); a1[c] += __shfl_xor(a1[c], 16); a1[c] += __shfl_xor(a1[c], 32); }
        if (kr == 0) { *(GAS f32x4*)(modpart + (size_t)(ks * 2 + 0) * (NMOD * D) + col) = a0; *(GAS f32x4*)(modpart + (size_t)(ks * 2 + 1) * (NMOD * D) + col) = a1; }
    }
    LAS float* scr = (LAS float*)(F.lds + 16384 + F.wave * 8704);
    constexpr int I_IN = (D / 64) * (DIN / 32), I_AO = (AW / 64) * (D / 32), I_CO = I_AO, I_O = (D / 64) * (D / 32);
    for (int it = gw; it < I_IN + I_AO + I_CO + I_O; it += NGW) {
        int r = it;
        if (r < I_IN) { const int nb = r % (DIN / 32), kb = r / (DIN / 32); transpose_item(a.w_in, D, DIN, (bf16_t*)(F.ws + WS_WIN), 64 * kb, 32 * nb, win_dest_row(32 * nb), scr, lane); continue; } r -= I_IN;
        if (r < I_AO) { const int nb = r % (D / 32), kb = r / (D / 32); transpose_item(a.w_attn_out, AW, D, (bf16_t*)(F.ws + WS_WAO), 64 * kb, 32 * nb, 32 * nb, scr, lane); continue; } r -= I_AO;
        if (r < I_CO) { const int nb = r % (D / 32), kb = r / (D / 32); transpose_item(a.w_conv_out, CWD, D, (bf16_t*)(F.ws + WS_WCO), 64 * kb, 32 * nb, 32 * nb, scr, lane); continue; } r -= I_CO;
        { const int nb = r % (D / 32), kb = r / (D / 32); transpose_item(a.w_o, D, D, (bf16_t*)(F.ws + WS_WO), 64 * kb, 32 * nb, 32 * nb, scr, lane); }
    }
    bf16_t* wrt = (bf16_t*)(F.ws + WS_WRT);
    for (int t = gw * 64 + lane; t < 48 * 128; t += NGW * 64) { const int kc = t / 48, c = t % 48; float v[8];
#pragma unroll
        for (int j = 0; j < 8; ++j) { const int k = kc * 8 + j; v[j] = c < NGRP ? a.w_rg[k * NGRP + c] : c < NGRP + NE ? a.w_re[k * NE + (c - NGRP)] : 0.f; }
        u32x4 o; o.x = cvt_pk_bf16(v[0], v[1]); o.y = cvt_pk_bf16(v[2], v[3]); o.z = cvt_pk_bf16(v[4], v[5]); o.w = cvt_pk_bf16(v[6], v[7]);
        *(GAS u32x4*)(wrt + (size_t)c * D + kc * 8) = o; }
}
__device__ __forceinline__ void p1_finalize(Frame& F, const Args& a) {
    const float* modpart = (const float*)(F.ws + WS_MODPART); float* modv = (float*)(F.ws + WS_MODV);
    for (int idx = F.tid * F.G + (int)blockIdx.x; idx < 2 * NMOD * D; idx += F.G * NTHR) {
        const int b = idx / (NMOD * D), j = idx % (NMOD * D), ch = j >> 10, k = j & 1023;
        float s = a.b_ada[j];
#pragma unroll
        for (int ks = 0; ks < MOD_KS; ++ks) s += modpart[(size_t)(ks * 2 + b) * (NMOD * D) + j];
        int v; float val = s;
        if (ch == 0) v = 1; else if (ch == 1) { v = 0; val = a.norm1_g[k] * (1.f + s); } else if (ch == 2) v = 2; else if (ch == 3) v = 4; else if (ch == 4) { v = 3; val = a.norm2_g[k] * (1.f + s); } else v = 5;
        modv[(size_t)(v * 2 + b) * D + k] = val;
    }
}
__device__ __forceinline__ void p2_h1_rows(Frame& F, const Args& a) {
    const float* modv = (const float*)(F.ws + WS_MODV);
    LAS float* mul = (LAS float*)F.lds; LAS float* add = mul + 2 * D;
    for (int i = F.tid; i < 2 * D / 4; i += NTHR) { *(LAS f32x4*)(mul + 4 * i) = *(const GAS f32x4*)(modv + 4 * i); *(LAS f32x4*)(add + 4 * i) = *(const GAS f32x4*)(modv + 2 * D + 4 * i); }
    __syncthreads();
    const int gw = F.vcu * NWAVES + F.wave, NGW = F.G * NWAVES, lane = F.lane;
    bf16_t* H1 = (bf16_t*)(F.ws + WS_R1);
    for (int m = gw; m < T; m += 2 * NGW) {
        const int m1 = (m + NGW < T) ? m + NGW : m;
        const GAS f32x4* xa = (const GAS f32x4*)(a.x + (size_t)m * D) + lane; const GAS f32x4* xb = (const GAS f32x4*)(a.x + (size_t)m1 * D) + lane;
        f32x4 va[4], vb[4]; float sa = 0.f, sb = 0.f;
#pragma unroll
        for (int j = 0; j < 4; ++j) { va[j] = xa[64 * j]; vb[j] = xb[64 * j]; }
#pragma unroll
        for (int j = 0; j < 4; ++j) { sa += (va[j].x * va[j].x + va[j].y * va[j].y) + (va[j].z * va[j].z + va[j].w * va[j].w); sb += (vb[j].x * vb[j].x + vb[j].y * vb[j].y) + (vb[j].z * vb[j].z + vb[j].w * vb[j].w); }
#pragma unroll
        for (int o = 1; o < 64; o <<= 1) { sa += __shfl_xor(sa, o); sb += __shfl_xor(sb, o); }
        const float ra = 1.f / sqrtf(sa * (1.f / D) + NORM_EPS), rb = 1.f / sqrtf(sb * (1.f / D) + NORM_EPS);
        const int ba = m / SEQ, bb = m1 / SEQ;
        GAS u32x2* oa = (GAS u32x2*)(H1 + (size_t)m * D) + lane; GAS u32x2* ob = (GAS u32x2*)(H1 + (size_t)m1 * D) + lane;
#pragma unroll
        for (int j = 0; j < 4; ++j) {
            const f32x4 ha = va[j] * ra * *(const LAS f32x4*)(mul + ba * D + 256 * j + 4 * lane) + *(const LAS f32x4*)(add + ba * D + 256 * j + 4 * lane);
            const f32x4 hb = vb[j] * rb * *(const LAS f32x4*)(mul + bb * D + 256 * j + 4 * lane) + *(const LAS f32x4*)(add + bb * D + 256 * j + 4 * lane);
            u32x2 o; o.x = cvt_pk_bf16(ha.x, ha.y); o.y = cvt_pk_bf16(ha.z, ha.w); oa[64 * j] = o;
            if (m1 != m) { u32x2 p; p.x = cvt_pk_bf16(hb.x, hb.y); p.y = cvt_pk_bf16(hb.z, hb.w); ob[64 * j] = p; } }
    }
}
struct EpiInProj {
    static constexpr bool PERM = true;
    bf16_t *Q, *Kb, *V, *U, *BG, *SA, *SC; const float* b_gate;
    __device__ __forceinline__ void operator()(const f32x4 (&acc)[2][2][4][2], const pg8::Unit& u, int wr, int wc, int fr, int fq) const {
        const int pn = u.pn, row0 = u.pm * 256 + wr * 64 + fr, colw = wc * 32 + 8 * fq;
        if (pn >= 6 && pn < 10) {
            const int ch0 = (pn - 6) * 128 + colw;
#pragma unroll
            for (int ai = 0; ai < 2; ++ai)
#pragma unroll
                for (int m = 0; m < 4; ++m) { const f32x4 v0 = acc[ai][0][m][0] * acc[ai][1][m][0], v1 = acc[ai][0][m][1] * acc[ai][1][m][1];
                    u32x4 w; w.x = cvt_pk_bf16(v0[0], v0[1]); w.y = cvt_pk_bf16(v0[2], v0[3]); w.z = cvt_pk_bf16(v1[0], v1[1]); w.w = cvt_pk_bf16(v1[2], v1[3]);
                    *(GAS u32x4*)(U + (size_t)(row0 + ai * 128 + m * 16) * 512 + ch0) = w; }
        } else if (pn >= 12) {
            bf16_t* dst = pn < 16 ? SA : SC; const int ct = (pn & 3) * 256, bt = (pn - 12) * 256;
#pragma unroll
            for (int bj = 0; bj < 2; ++bj) { const f32x4 b0 = *(const GAS f32x4*)(b_gate + bt + bj * 128 + colw), b1 = *(const GAS f32x4*)(b_gate + bt + bj * 128 + colw + 4);
#pragma unroll
                for (int ai = 0; ai < 2; ++ai)
#pragma unroll
                    for (int m = 0; m < 4; ++m) { const f32x4 v0 = acc[ai][bj][m][0] + b0, v1 = acc[ai][bj][m][1] + b1;
                        u32x4 w; w.x = cvt_pk_bf16(sigmoidf_(v0[0]), sigmoidf_(v0[1])); w.y = cvt_pk_bf16(sigmoidf_(v0[2]), sigmoidf_(v0[3]));
                        w.z = cvt_pk_bf16(sigmoidf_(v1[0]), sigmoidf_(v1[1])); w.w = cvt_pk_bf16(sigmoidf_(v1[2]), sigmoidf_(v1[3]));
                        *(GAS u32x4*)(dst + (size_t)(row0 + ai * 128 + m * 16) * 1024 + ct + bj * 128 + colw) = w; } }
        } else {
            bf16_t* dst = pn < 2 ? Q : pn < 4 ? Kb : pn < 6 ? V : BG; const float sc = pn < 2 ? QSCALE : 1.f; const int ct = (pn & 1) * 256;
#pragma unroll
            for (int ai = 0; ai < 2; ++ai)
#pragma unroll
                for (int m = 0; m < 4; ++m)
#pragma unroll
                    for (int bj = 0; bj < 2; ++bj) { const f32x4 v0 = acc[ai][bj][m][0] * sc, v1 = acc[ai][bj][m][1] * sc;
                        u32x4 w; w.x = cvt_pk_bf16(v0[0], v0[1]); w.y = cvt_pk_bf16(v0[2], v0[3]); w.z = cvt_pk_bf16(v1[0], v1[1]); w.w = cvt_pk_bf16(v1[2], v1[3]);
                        *(GAS u32x4*)(dst + (size_t)(row0 + ai * 128 + m * 16) * 512 + ct + bj * 128 + colw) = w; }
        }
    }
};

__device__ __forceinline__ void p3_kmean(Frame& F) {
    const bf16_t* Kb = (const bf16_t*)(F.ws + WS_K); float* kmean = (float*)(F.ws + WS_KMEAN); float* kmax = (float*)(F.ws + WS_KMAX);
    LAS float* red = (LAS float*)F.lds;
    LAS float* red2 = red + 32 * 128;
    for (int it = F.vcu; it < BATCH * NBLK * 4; it += F.G) {
        const int bn = it >> 2, cq = it & 3, cc = F.tid & 15, rg = F.tid >> 4;
        float s[8] = {0.f, 0.f, 0.f, 0.f, 0.f, 0.f, 0.f, 0.f}; float nmax = 0.f;
#pragma unroll
        for (int r = 0; r < 8; ++r) { const u32x4 v = *(const GAS u32x4*)(Kb + (size_t)(bn * 256 + rg * 8 + r) * 512 + cq * 128 + cc * 8);
            const float e0 = bf_lo(v.x), e1 = bf_hi(v.x), e2 = bf_lo(v.y), e3 = bf_hi(v.y), e4 = bf_lo(v.z), e5 = bf_hi(v.z), e6 = bf_lo(v.w), e7 = bf_hi(v.w);
            s[0] += e0; s[1] += e1; s[2] += e2; s[3] += e3; s[4] += e4; s[5] += e5; s[6] += e6; s[7] += e7;
            float q = (e0 * e0 + e1 * e1) + (e2 * e2 + e3 * e3) + (e4 * e4 + e5 * e5) + (e6 * e6 + e7 * e7);
            q += __shfl_xor(q, 1); q += __shfl_xor(q, 2); q += __shfl_xor(q, 4);
            nmax = fmaxf(nmax, q); }
#pragma unroll
        for (int j = 0; j < 8; ++j) red[rg * 128 + cc * 8 + j] = s[j];
        if ((cc & 7) == 0) red2[rg * 2 + (cc >> 3)] = nmax;
        __syncthreads();
        if (F.tid < 128) { float t = 0.f;
#pragma unroll
            for (int g = 0; g < 32; ++g) t += red[g * 128 + F.tid];
            kmean[(size_t)bn * 512 + cq * 128 + F.tid] = t * (1.f / 256.f); }
        if (F.tid < 2) { float m = 0.f;
#pragma unroll
            for (int g = 0; g < 32; ++g) m = fmaxf(m, red2[g * 2 + F.tid]);
            const int b = bn >> 5, n = bn & 31, h = cq * 2 + F.tid; kmax[(b * NH + h) * NBLK + n] = sqrtf(m); }
        __syncthreads();
    }
}

__device__ __forceinline__ void p4_topk(Frame& F) {
    const bf16_t* Q = (const bf16_t*)(F.ws + WS_Q); const float* kmean = (const float*)(F.ws + WS_KMEAN);
    unsigned* qcnt = F.ctl + CW_QCNT; unsigned* list = (unsigned*)(F.ws + WS_LIST);
    LAS float* km = (LAS float*)F.lds;
    LAS unsigned* lcnt = (LAS unsigned*)(F.lds + 16384);
    LAS unsigned* lbase = lcnt + 64;
    float* QN = (float*)(F.ws + WS_QN);
    for (int it = F.vcu; it < BATCH * NBLK * 4; it += F.G) {
        const int hp = it & 3, qb = (NBLK - 1) - (it >> 2) % NBLK, b = (it >> 2) / NBLK;
        for (int i = F.tid; i < 2 * qb * 16; i += NTHR) { const int hl = i / (qb * 16), r = i % (qb * 16), n = r >> 4, c4 = r & 15;
            *(LAS f32x4*)(km + (hl * 32 + n) * 64 + c4 * 4) = *(const GAS f32x4*)(kmean + (size_t)(b * NBLK + n) * 512 + (2 * hp + hl) * 64 + c4 * 4); }
        if (F.tid < 128) lcnt[F.tid] = 0u;
        __syncthreads();
        const int ql = F.tid & 255, hl = F.tid >> 8, h = 2 * hp + hl, t = qb * 256 + ql;
        float q[64];
        { const GAS u32x4* qp = (const GAS u32x4*)(Q + (size_t)(b * SEQ + t) * 512 + h * 64);
#pragma unroll
          for (int c = 0; c < 8; ++c) { const u32x4 v = qp[c]; q[8 * c] = bf_lo(v.x); q[8 * c + 1] = bf_hi(v.x); q[8 * c + 2] = bf_lo(v.y); q[8 * c + 3] = bf_hi(v.y); q[8 * c + 4] = bf_lo(v.z); q[8 * c + 5] = bf_hi(v.z); q[8 * c + 6] = bf_lo(v.w); q[8 * c + 7] = bf_hi(v.w); } }
        { float qq = 0.f;
#pragma unroll
          for (int c = 0; c < 64; ++c) qq += q[c] * q[c];
          QN[(size_t)(b * SEQ + t) * NH + h] = sqrtf(qq); }
        if (qb == 0) continue;
        float v0 = -3e38f, v1 = -3e38f, v2 = -3e38f; int i0 = 0, i1 = 0, i2 = 0;
#pragma unroll 2
        for (int n = 0; n < qb; ++n) {
            const LAS f32x4* kp = (const LAS f32x4*)(km + (hl * 32 + n) * 64); float g = 0.f;
#pragma unroll
            for (int c = 0; c < 16; ++c) { const f32x4 kv = kp[c]; g += q[4 * c] * kv.x + q[4 * c + 1] * kv.y + q[4 * c + 2] * kv.z + q[4 * c + 3] * kv.w; }
            if (g > v0) { v2 = v1; i2 = i1; v1 = v0; i1 = i0; v0 = g; i0 = n; }
            else if (g > v1) { v2 = v1; i2 = i1; v1 = g; i1 = n; }
            else if (g > v2) { v2 = g; i2 = n; }
        }
        const int nsel = qb < TOPK ? qb : TOPK;
        unsigned p0 = 0, p1 = 0, p2 = 0;
        p0 = __hip_atomic_fetch_add(&lcnt[hl * 32 + i0], 1u, __ATOMIC_RELAXED, __HIP_MEMORY_SCOPE_WORKGROUP);
        if (nsel > 1) p1 = __hip_atomic_fetch_add(&lcnt[hl * 32 + i1], 1u, __ATOMIC_RELAXED, __HIP_MEMORY_SCOPE_WORKGROUP);
        if (nsel > 2) p2 = __hip_atomic_fetch_add(&lcnt[hl * 32 + i2], 1u, __ATOMIC_RELAXED, __HIP_MEMORY_SCOPE_WORKGROUP);
        __syncthreads();
        if (F.tid < 64) { const int hl2 = F.tid >> 5, n = F.tid & 31; const unsigned c = lcnt[F.tid];
            lbase[F.tid] = c ? atomicAdd(&qcnt[(b * NH + 2 * hp + hl2) * NBLK + n], c) : 0u; }
        __syncthreads();
        const size_t lb = (size_t)((b * NH + h) * NBLK);
        list[(lb + i0) * CAPQ + lbase[hl * 32 + i0] + p0] = (unsigned)t | (0u << 13);
        if (nsel > 1) list[(lb + i1) * CAPQ + lbase[hl * 32 + i1] + p1] = (unsigned)t | (1u << 13);
        if (nsel > 2) list[(lb + i2) * CAPQ + lbase[hl * 32 + i2] + p2] = (unsigned)t | (2u << 13);
        __syncthreads();
    }
}

__device__ __forceinline__ int crow(int r, int hi) { return (r & 3) + 8 * (r >> 2) + 4 * hi; }
__device__ __forceinline__ float swap_max(float m) { auto rr = __builtin_amdgcn_permlane32_swap(__float_as_uint(m), __float_as_uint(m), false, false); return fmaxf(__uint_as_float(rr[0]), __uint_as_float(rr[1])); }
__device__ __forceinline__ float swap_sum(float m) { auto rr = __builtin_amdgcn_permlane32_swap(__float_as_uint(m), __float_as_uint(m), false, false); return __uint_as_float(rr[0]) + __uint_as_float(rr[1]); }
__device__ __forceinline__ s16x4 vtr(const LAS unsigned char* p) { return __builtin_bit_cast(s16x4, __builtin_amdgcn_ds_read_tr16_b64_v4i16((LAS s16x4*)p)); }
constexpr int AT_KV = 0, AT_OST = 131072, AT_LW = 147456, AT_META = 148480, AT_TAB = 149504, AT_PFX = 153728, AT_QCL = 155904, AT_KMX = 157952;
struct AttItem { int idx, j, own, nvalid; };
__device__ __forceinline__ AttItem att_decode(const LAS int* pfx, const LAS int* qcl, int it) {
    int lo = 0, hh = 511;
#pragma unroll 1
    while (lo < hh) { const int mid = (lo + hh + 1) >> 1; if (pfx[mid] <= it) lo = mid; else hh = mid - 1; }
    AttItem r; r.idx = lo; r.j = it - pfx[lo]; const int nch = pfx[lo + 1] - pfx[lo] - 1; r.own = (r.j == nch);
    const int rem = qcl[lo] - r.j * 256; r.nvalid = r.own ? 256 : (rem < 256 ? rem : 256); return r;
}
__device__ __forceinline__ void p5_attention(Frame& F, const Args& a) {
    const bf16_t* Q = (const bf16_t*)(F.ws + WS_Q); const bf16_t* Kb = (const bf16_t*)(F.ws + WS_K); const bf16_t* V = (const bf16_t*)(F.ws + WS_V);
    bf16_t* OP = (bf16_t*)(F.ws + WS_OPART); float* ML = (float*)(F.ws + WS_ML); const float* QN = (const float*)(F.ws + WS_QN);
    const unsigned* qcnt = F.ctl + CW_QCNT; const unsigned* list = (const unsigned*)(F.ws + WS_LIST);
    LAS unsigned char* lds = F.lds; const int tid = F.tid, lane = F.lane, w = F.wave, r32 = lane & 31, hi = lane >> 5;
    LAS float* tab = (LAS float*)(lds + AT_TAB); LAS int* pfx = (LAS int*)(lds + AT_PFX); LAS int* qcl = (LAS int*)(lds + AT_QCL); LAS float* kmx = (LAS float*)(lds + AT_KMX);
    for (int i = tid; i < NH * 129; i += NTHR) { const int h = i / 129, e = i % 129; float v = -INFINITY;
        if (e >= 1) { const int d = e - 1; int bk;
            if (d < 16) bk = d; else { bk = 16 + (d >= 19) + (d >= 21) + (d >= 24) + (d >= 27) + (d >= 31) + (d >= 35) + (d >= 40) + (d >= 46) + (d >= 52) + (d >= 59) + (d >= 67) + (d >= 77) + (d >= 87) + (d >= 99) + (d >= 113); }
            v = (a.rel_bias[bk * NH + h] - a.rel_bias[31 * NH + h]) * LOG2E; }
        tab[h * 132 + e] = v; }
    { const int c = (int)qcnt[tid]; qcl[tid] = c; pfx[tid + 1] = (c + 255) / 256 + 1; if (tid == 0) pfx[0] = 0; kmx[tid] = ((const float*)(F.ws + WS_KMAX))[tid]; }
    __syncthreads();
    if (tid < NH) { float mx = 0.f, mn = 0.f; for (int e = 1; e <= 128; ++e) { const float v = tab[tid * 132 + e]; mx = fmaxf(mx, v); mn = fminf(mn, v); }
        tab[tid * 132 + 129] = mx; tab[tid * 132 + 130] = a.rel_bias[31 * NH + tid] * LOG2E; tab[tid * 132 + 131] = mx - mn; }
    for (int o = 1; o < 512; o <<= 1) { int v = pfx[tid + 1]; if (tid >= o) v += pfx[tid + 1 - o]; __syncthreads(); pfx[tid + 1] = v; __syncthreads(); }
    const int nitems = pfx[512];
    LAS float* lw = (LAS float*)(lds + AT_LW) + w * 32; LAS unsigned* meta = (LAS unsigned*)(lds + AT_META) + w * 32;
    LAS bf16_t* stg = (LAS bf16_t*)(lds + AT_OST) + w * 1024;
    const int rowi = 32 * w + r32;
    const unsigned kv_lofs = (unsigned)((tid >> 3) * 1024 + (tid & 7) * 16);
    const unsigned k_lds = (unsigned)((tid >> 3) * 128 + (((tid & 7) ^ ((tid >> 4) & 7)) << 4));
    const unsigned v_lds = (unsigned)(32768 + (tid >> 3) * 128 + (((tid & 7) ^ (((tid >> 4) & 1) << 2)) << 4));
#define AT_K_LOAD(IDX) do { const int n_ = (IDX) & 31, h_ = ((IDX) >> 5) & 7, b_ = (IDX) >> 8; const char* gb_ = (const char*)(Kb + ((size_t)(b_ * SEQ + n_ * 256)) * 512 + h_ * 64); \
        _Pragma("unroll") for (int i_ = 0; i_ < 4; ++i_) kvreg[i_] = *(const GAS u32x4*)(gb_ + (size_t)i_ * 65536 + kv_lofs); } while (0)
#define AT_V_LOAD(IDX) do { const int n_ = (IDX) & 31, h_ = ((IDX) >> 5) & 7, b_ = (IDX) >> 8; const char* gb_ = (const char*)(V + ((size_t)(b_ * SEQ + n_ * 256)) * 512 + h_ * 64); \
        _Pragma("unroll") for (int i_ = 0; i_ < 4; ++i_) kvreg[i_] = *(const GAS u32x4*)(gb_ + (size_t)i_ * 65536 + kv_lofs); } while (0)
#define AT_K_WRITE(BUFO) do { _Pragma("unroll") for (int i_ = 0; i_ < 4; ++i_) *(LAS u32x4*)(lds + (BUFO) + k_lds + i_ * 8192) = kvreg[i_]; } while (0)
#define AT_V_WRITE(BUFO) do { _Pragma("unroll") for (int i_ = 0; i_ < 4; ++i_) *(LAS u32x4*)(lds + (BUFO) + v_lds + i_ * 8192) = kvreg[i_]; } while (0)
#define AT_ENT(IT, OUT) do { const int n_ = (IT).idx & 31; const bool v_ = rowi < (IT).nvalid; \
        OUT = (IT).own ? ((unsigned)(n_ * 256 + rowi) | (3u << 13)) : list[(size_t)(IT).idx * CAPQ + (IT).j * 256 + (v_ ? rowi : 0)]; } while (0)
#define AT_Q_LOAD(IT, ENT, QF, QNV) do { const int h_ = ((IT).idx >> 5) & 7, b_ = (IT).idx >> 8; const int t_ = (int)((ENT) & 8191u); \
        const GAS bf16x8* qp_ = (const GAS bf16x8*)(Q + (size_t)(b_ * SEQ + t_) * 512 + h_ * 64 + 8 * hi); \
        _Pragma("unroll") for (int s_ = 0; s_ < 4; ++s_) QF[s_] = qp_[2 * s_]; QNV = QN[(size_t)(b_ * SEQ + t_) * NH + h_]; } while (0)
    int it = F.vcu; int buf = 0;
    AttItem cur; cur.idx = 0; cur.j = 0; cur.own = 1; cur.nvalid = 0;
    u32x4 kvreg[4]; bf16x8 qf[4]; float qn = 0.f; unsigned ent = 0u;
    if (it < nitems) { cur = att_decode(pfx, qcl, it); AT_K_LOAD(cur.idx); AT_ENT(cur, ent); AT_K_WRITE(AT_KV); AT_V_LOAD(cur.idx); AT_Q_LOAD(cur, ent, qf, qn); AT_V_WRITE(AT_KV); }
    for (; it < nitems; it += F.G, buf ^= 1) {
        const int idx = cur.idx; const bool own = cur.own != 0; const int nvalid = cur.nvalid;
        const int n = idx & 31, h = (idx >> 5) & 7, b = idx >> 8;
        const bool valid = rowi < nvalid;
        const int tq = (int)(ent & 8191u), slot = (int)(ent >> 13) & 3;
        if (hi == 0) meta[r32] = (unsigned)tq | ((unsigned)slot << 13) | (valid ? 0x8000u : 0u);
        const bool has_next = it + F.G < nitems;
        AttItem nxt = cur; unsigned ent_n = ent;
        if (has_next) { nxt = att_decode(pfx, qcl, it + F.G); AT_ENT(nxt, ent_n); }
        asm volatile("s_waitcnt lgkmcnt(0)" ::: "memory"); __builtin_amdgcn_s_barrier(); asm volatile("" ::: "memory");
        if (has_next) AT_K_LOAD(nxt.idx);
        const LAS unsigned char* kt = lds + AT_KV + buf * 65536; const LAS unsigned char* vt = kt + 32768;
        const bool active = 32 * w < nvalid;
        const int imax = own ? w : 7;
        const int kbase = n * 256; const LAS float* tb = tab + h * 132; const int dq = tq - kbase - 4 * hi + 1;
        f32x16 p[8]; float mref = 0.f, ls = 0.f;
        if (active) {
            const float kq = qn * kmx[idx];
            mref = kq + tb[129];
            if (__any(valid && (2.f * kq + tb[131] > 100.f))) {
                float mx = -INFINITY;
#pragma unroll
                for (int i = 0; i < 8; ++i) if (i <= imax) { const int row = 32 * i + r32; const LAS unsigned char* kr = kt + row * 128; const int sw = (row >> 1) & 7;
                    f32x16 accp = {0.f, 0.f, 0.f, 0.f, 0.f, 0.f, 0.f, 0.f, 0.f, 0.f, 0.f, 0.f, 0.f, 0.f, 0.f, 0.f};
#pragma unroll
                    for (int s = 0; s < 4; ++s) { const bf16x8 kf = *(const LAS bf16x8*)(kr + (((2 * s + hi) ^ sw) << 4)); accp = __builtin_amdgcn_mfma_f32_32x32x16_bf16(kf, qf[s], accp, 0, 0, 0); }
#pragma unroll
                    for (int r = 0; r < 16; ++r) { int di = dq - 32 * i - ((r & 3) + 8 * (r >> 2)); di = di < 0 ? 0 : (di > 128 ? 128 : di); mx = fmaxf(mx, accp[r] + tb[di]); } }
                mref = swap_max(mx);
            }
            { const float ni = -mref; const f32x16 init = {ni, ni, ni, ni, ni, ni, ni, ni, ni, ni, ni, ni, ni, ni, ni, ni};
#pragma unroll
              for (int i = 0; i < 8; ++i) if (i <= imax) { const int row = 32 * i + r32; const LAS unsigned char* kr = kt + row * 128; const int sw = (row >> 1) & 7;
                  f32x16 accp = init;
#pragma unroll
                  for (int s = 0; s < 4; ++s) { const bf16x8 kf = *(const LAS bf16x8*)(kr + (((2 * s + hi) ^ sw) << 4)); accp = __builtin_amdgcn_mfma_f32_32x32x16_bf16(kf, qf[s], accp, 0, 0, 0); }
                  p[i] = accp; } }
        }
        if (has_next) { AT_K_WRITE(AT_KV + (buf ^ 1) * 65536); AT_V_LOAD(nxt.idx); }
        if (active) {
#pragma unroll
            for (int i = 0; i < 8; ++i) if (i <= imax) {
                if (__any(valid && (tq - kbase - 32 * i - 31 < 127))) {
#pragma unroll
                    for (int r = 0; r < 16; ++r) { int di = dq - 32 * i - ((r & 3) + 8 * (r >> 2)); di = di < 0 ? 0 : (di > 128 ? 128 : di); p[i][r] += tb[di]; } } }
#pragma unroll
            for (int i = 0; i < 8; ++i) if (i <= imax) {
#pragma unroll
                for (int r = 0; r < 16; ++r) { const float e = __builtin_amdgcn_exp2f(p[i][r]); p[i][r] = e; ls += e; } }
            ls = swap_sum(ls);
        }
        if (has_next) AT_V_WRITE(AT_KV + (buf ^ 1) * 65536);
        if (active) {
            f32x16 o0 = {0.f, 0.f, 0.f, 0.f, 0.f, 0.f, 0.f, 0.f, 0.f, 0.f, 0.f, 0.f, 0.f, 0.f, 0.f, 0.f}, o1 = o0;
            { const int L = lane & 15, qq = L >> 2, pp = L & 3, sq = (qq >> 1) & 1, cc = 2 * ((lane >> 4) & 1) + (pp >> 1);
              const LAS unsigned char* vb0 = vt + (4 * hi + qq) * 128 + ((4 * sq + cc) << 4) + (pp & 1) * 8;
              const LAS unsigned char* vb1 = vt + (4 * hi + qq) * 128 + ((4 * (1 ^ sq) + cc) << 4) + (pp & 1) * 8;
#pragma unroll
              for (int i = 0; i < 8; ++i) if (i <= imax) {
#pragma unroll
                  for (int s2 = 0; s2 < 2; ++s2) {
                      u32x4 pw; pw.x = cvt_pk_bf16(p[i][8 * s2 + 0], p[i][8 * s2 + 1]); pw.y = cvt_pk_bf16(p[i][8 * s2 + 2], p[i][8 * s2 + 3]); pw.z = cvt_pk_bf16(p[i][8 * s2 + 4], p[i][8 * s2 + 5]); pw.w = cvt_pk_bf16(p[i][8 * s2 + 6], p[i][8 * s2 + 7]);
                      const bf16x8 pa = __builtin_bit_cast(bf16x8, pw); const int off = (32 * i + 16 * s2) * 128;
                      const s16x4 a0 = vtr(vb0 + off), a1 = vtr(vb0 + off + 1024), c0 = vtr(vb1 + off), c1 = vtr(vb1 + off + 1024);
                      const bf16x8 vf0 = {a0[0], a0[1], a0[2], a0[3], a1[0], a1[1], a1[2], a1[3]}, vf1 = {c0[0], c0[1], c0[2], c0[3], c1[0], c1[1], c1[2], c1[3]};
                      o0 = __builtin_amdgcn_mfma_f32_32x32x16_bf16(pa, vf0, o0, 0, 0, 0); o1 = __builtin_amdgcn_mfma_f32_32x32x16_bf16(pa, vf1, o1, 0, 0, 0); } } }
            if (has_next) AT_Q_LOAD(nxt, ent_n, qf, qn);
            if (hi == 0) { lw[r32] = ls; if (valid) ML[((size_t)(b * SEQ + tq) * NH + h) * 4 + slot] = mref + __builtin_amdgcn_logf(ls) + tb[130]; }
            LDS_WAIT();
            float rl[16];
#pragma unroll
            for (int r = 0; r < 16; ++r) rl[r] = __builtin_amdgcn_rcpf(lw[crow(r, hi)]);
#pragma unroll
            for (int d0 = 0; d0 < 2; ++d0) {
#pragma unroll
                for (int r = 0; r < 16; ++r) stg[crow(r, hi) * 32 + r32] = (bf16_t)(cvt_pk_bf16((d0 ? o1[r] : o0[r]) * rl[r], 0.f) & 0xffffu);
                LDS_WAIT();
#pragma unroll
                for (int i = 0; i < 2; ++i) { const int id = lane + 64 * i, row = id >> 2, ch = id & 3; const unsigned mt = meta[row];
                    if (mt & 0x8000u) { const u32x4 v = *(const LAS u32x4*)(stg + row * 32 + ch * 8); const int tt = (int)(mt & 8191u), sl = (int)(mt >> 13) & 3;
                        *(GAS u32x4*)(OP + (((size_t)(b * SEQ + tt) * NH + h) * 4 + sl) * 64 + d0 * 32 + ch * 8) = v; } }
                LDS_WAIT();
            }
        }
        if (!active && has_next) AT_Q_LOAD(nxt, ent_n, qf, qn);
        cur = nxt; ent = ent_n;
    }
#undef AT_K_LOAD
#undef AT_V_LOAD
#undef AT_K_WRITE
#undef AT_V_WRITE
#undef AT_ENT
#undef AT_Q_LOAD
    __syncthreads();
}

__device__ __forceinline__ void p6_combine_conv(Frame& F, const Args& a) {
    const bf16_t* OP = (const bf16_t*)(F.ws + WS_OPART); const float* ML = (const float*)(F.ws + WS_ML);
    const bf16_t* U = (const bf16_t*)(F.ws + WS_U); const bf16_t* BG = (const bf16_t*)(F.ws + WS_BG);
    bf16_t* ATT = (bf16_t*)(F.ws + WS_R1); bf16_t* CV = ATT + (size_t)T * 512;
    const int gw = F.vcu * NWAVES + F.wave, NGW = F.G * NWAVES, lane = F.lane;
    float cw[3][8];
#pragma unroll
    for (int j = 0; j < 3; ++j)
#pragma unroll
        for (int c = 0; c < 8; ++c) cw[j][c] = a.conv_w[j * CWD + lane * 8 + c];
    const int hd = lane >> 3, ch = lane & 7;
    for (int t0 = gw; t0 < T; t0 += 2 * NGW) {
        int tg[2]; tg[0] = t0; tg[1] = (t0 + NGW < T) ? t0 + NGW : t0;
        f32x4 l4[2]; u32x4 ov[2][4], uv[2][3], gv[2];
#pragma unroll
        for (int q = 0; q < 2; ++q) { const int tb = tg[q] & (SEQ - 1), qb = tb >> 8, nsel = qb < TOPK ? qb : TOPK; const size_t pb = ((size_t)tg[q] * NH + hd) * 4;
            l4[q] = *(const GAS f32x4*)(ML + pb);
#pragma unroll
            for (int sl = 0; sl < 4; ++sl) ov[q][sl] = (sl == 3 || sl < nsel) ? *(const GAS u32x4*)(OP + (pb + sl) * 64 + ch * 8) : (u32x4){0u, 0u, 0u, 0u};
            uv[q][2] = *(const GAS u32x4*)(U + (size_t)tg[q] * 512 + lane * 8);
            uv[q][1] = tb >= 1 ? *(const GAS u32x4*)(U + (size_t)(tg[q] - 1) * 512 + lane * 8) : (u32x4){0u, 0u, 0u, 0u};
            uv[q][0] = tb >= 2 ? *(const GAS u32x4*)(U + (size_t)(tg[q] - 2) * 512 + lane * 8) : (u32x4){0u, 0u, 0u, 0u};
            gv[q] = *(const GAS u32x4*)(BG + (size_t)tg[q] * 512 + lane * 8); }
#pragma unroll
        for (int q = 0; q < 2; ++q) if (q == 0 || tg[1] != tg[0]) { const int tb = tg[q] & (SEQ - 1), qb = tb >> 8, nsel = qb < TOPK ? qb : TOPK;
            const float ls[4] = {l4[q].x, l4[q].y, l4[q].z, l4[q].w}; float M = ls[3];
#pragma unroll
            for (int sl = 0; sl < 3; ++sl) if (sl < nsel) M = fmaxf(M, ls[sl]);
            float acc[8] = {0.f, 0.f, 0.f, 0.f, 0.f, 0.f, 0.f, 0.f}; float W = 0.f;
#pragma unroll
            for (int sl = 0; sl < 4; ++sl) if (sl == 3 || sl < nsel) { const float wg = __builtin_amdgcn_exp2f(ls[sl] - M); W += wg; const u32x4 v = ov[q][sl];
                acc[0] += wg * bf_lo(v.x); acc[1] += wg * bf_hi(v.x); acc[2] += wg * bf_lo(v.y); acc[3] += wg * bf_hi(v.y); acc[4] += wg * bf_lo(v.z); acc[5] += wg * bf_hi(v.z); acc[6] += wg * bf_lo(v.w); acc[7] += wg * bf_hi(v.w); }
            const float rW = 1.f / W;
            { u32x4 o; o.x = cvt_pk_bf16(acc[0] * rW, acc[1] * rW); o.y = cvt_pk_bf16(acc[2] * rW, acc[3] * rW); o.z = cvt_pk_bf16(acc[4] * rW, acc[5] * rW); o.w = cvt_pk_bf16(acc[6] * rW, acc[7] * rW);
              *(GAS u32x4*)(ATT + (size_t)tg[q] * 512 + lane * 8) = o; }
            float y[8] = {0.f, 0.f, 0.f, 0.f, 0.f, 0.f, 0.f, 0.f};
#pragma unroll
            for (int j = 0; j < 3; ++j) { const u32x4 v = uv[q][j];
                y[0] += cw[j][0] * bf_lo(v.x); y[1] += cw[j][1] * bf_hi(v.x); y[2] += cw[j][2] * bf_lo(v.y); y[3] += cw[j][3] * bf_hi(v.y); y[4] += cw[j][4] * bf_lo(v.z); y[5] += cw[j][5] * bf_hi(v.z); y[6] += cw[j][6] * bf_lo(v.w); y[7] += cw[j][7] * bf_hi(v.w); }
            { const u32x4 g = gv[q];
              u32x4 o; o.x = cvt_pk_bf16(y[0] * bf_lo(g.x), y[1] * bf_hi(g.x)); o.y = cvt_pk_bf16(y[2] * bf_lo(g.y), y[3] * bf_hi(g.y)); o.z = cvt_pk_bf16(y[4] * bf_lo(g.z), y[5] * bf_hi(g.z)); o.w = cvt_pk_bf16(y[6] * bf_lo(g.w), y[7] * bf_hi(g.w));
              *(GAS u32x4*)(CV + (size_t)tg[q] * 512 + lane * 8) = o; } }
    }
}

template <bool ADD> struct EpiGate {
    static constexpr bool PERM = true;
    bf16_t* MG; const bf16_t* S;
    __device__ __forceinline__ void operator()(const f32x4 (&acc)[2][2][4][2], const pg8::Unit& u, int wr, int wc, int fr, int fq) const {
        const int row0 = u.pm * 256 + wr * 64 + fr, col0 = u.pn * 256 + wc * 32 + 8 * fq;
#pragma unroll
        for (int ai = 0; ai < 2; ++ai)
#pragma unroll
            for (int m = 0; m < 4; ++m)
#pragma unroll
                for (int bj = 0; bj < 2; ++bj) { const size_t off = (size_t)(row0 + ai * 128 + m * 16) * 1024 + col0 + bj * 128;
                    const u32x4 g = *(const GAS u32x4*)(S + off); const f32x4 a0 = acc[ai][bj][m][0], a1 = acc[ai][bj][m][1];
                    float v[8] = {a0[0] * bf_lo(g.x), a0[1] * bf_hi(g.x), a0[2] * bf_lo(g.y), a0[3] * bf_hi(g.y), a1[0] * bf_lo(g.z), a1[1] * bf_hi(g.z), a1[2] * bf_lo(g.w), a1[3] * bf_hi(g.w)};
                    if constexpr (ADD) { const u32x4 pz = *(const GAS u32x4*)(MG + off);
                        v[0] += bf_lo(pz.x); v[1] += bf_hi(pz.x); v[2] += bf_lo(pz.y); v[3] += bf_hi(pz.y); v[4] += bf_lo(pz.z); v[5] += bf_hi(pz.z); v[6] += bf_lo(pz.w); v[7] += bf_hi(pz.w); }
                    u32x4 w; w.x = cvt_pk_bf16(v[0], v[1]); w.y = cvt_pk_bf16(v[2], v[3]); w.z = cvt_pk_bf16(v[4], v[5]); w.w = cvt_pk_bf16(v[6], v[7]);
                    *(GAS u32x4*)(MG + off) = w; }
    }
};
struct EpiResid {
    static constexpr bool PERM = false;
    const float* x; float* X1; const float* g1;
    __device__ __forceinline__ void operator()(const f32x4 (&acc)[2][2][4][2], const pg8::Unit& u, int wr, int wc, int fr, int fq) const {
        const int row0 = u.pm * 256 + wr * 64 + fr, col0 = u.pn * 256 + wc * 32 + 4 * fq; const int b = (u.pm * 256) / SEQ;
        f32x4 gv[2][2];
#pragma unroll
        for (int bj = 0; bj < 2; ++bj)
#pragma unroll
            for (int n = 0; n < 2; ++n) gv[bj][n] = *(const GAS f32x4*)(g1 + (size_t)b * D + col0 + bj * 128 + n * 16);
#pragma unroll
        for (int ai = 0; ai < 2; ++ai)
#pragma unroll
            for (int m = 0; m < 4; ++m) { const size_t ro = (size_t)(row0 + ai * 128 + m * 16) * D + col0;
#pragma unroll
                for (int bj = 0; bj < 2; ++bj)
#pragma unroll
                    for (int n = 0; n < 2; ++n) { const f32x4 xv = *(const GAS f32x4*)(x + ro + bj * 128 + n * 16); *(GAS f32x4*)(X1 + ro + bj * 128 + n * 16) = xv + gv[bj][n] * acc[ai][bj][m][n]; } }
    }
};

__device__ __forceinline__ void p9_norm_route(Frame& F, const Args& a) {
    const int gw = F.vcu * NWAVES + F.wave, NGW = F.G * NWAVES, lane = F.lane, tid = F.tid;
#ifndef PROBE_PH
#define PROBE_PH (-1)
#endif
    for (int rep_ = 0; rep_ < ((PROBE_PH) == 90 ? 2 : 1); ++rep_)
    {
        LAS float* scr = (LAS float*)(F.lds + F.wave * 8704);
        constexpr int I_G = (D / 64) * (DE / 32), I_D = (DE / 64) * (D / 32), PER_E = 2 * I_G + I_D;
        for (int it = gw; it < NE * PER_E; it += NGW) {
            const int e = it / PER_E; int r = it % PER_E;
            bf16_t* wgu = (bf16_t*)(F.ws + WS_WGU) + (size_t)e * 1024 * 1024; bf16_t* wd = (bf16_t*)(F.ws + WS_WD) + (size_t)e * 1024 * 512;
            if (r < 2 * I_G) { const int up = r >= I_G; if (up) r -= I_G; const int nb = r % (DE / 32), kb = r / (DE / 32), n0 = 32 * nb;
                transpose_item((up ? a.w_eu : a.w_eg) + (size_t)e * D * DE, D, DE, wgu, 64 * kb, n0, 256 * (n0 >> 7) + (n0 & 127) + (up ? 128 : 0), scr, lane); }
            else { r -= 2 * I_G; const int nb = r % (D / 32), kb = r / (D / 32); transpose_item(a.w_ed + (size_t)e * DE * D, DE, D, wd, 64 * kb, 32 * nb, 32 * nb, scr, lane); }
        }
    }
    __syncthreads();
    LAS unsigned char* wrl = F.lds;
    LAS float* mul = (LAS float*)(F.lds + 99328); LAS float* add = mul + 2 * D;
    LAS float* ssq = (LAS float*)(F.lds + 115712);
    LAS float* lgx = (LAS float*)(F.lds + 116224);
    LAS float* rb = (LAS float*)(F.lds + 140800);
    LAS int* asg_e = (LAS int*)(F.lds + 141056);
    LAS unsigned* asg_p = (LAS unsigned*)(asg_e + 128);
    LAS float* asg_w = (LAS float*)(asg_p + 128);
    LAS unsigned* lcnt = (LAS unsigned*)(asg_w + 128);
    LAS unsigned* lbase = lcnt + 32;
    { const bf16_t* wrt = (const bf16_t*)(F.ws + WS_WRT); const float* modv = (const float*)(F.ws + WS_MODV);
#pragma unroll
      for (int i = 0; i < 12; ++i) { const int id = tid + NTHR * i, c = id >> 7, kc = id & 127; *(LAS u32x4*)(wrl + (c * 1032 + kc * 8) * 2) = *(const GAS u32x4*)(wrt + (size_t)c * D + kc * 8); }
      *(LAS f32x4*)(mul + 4 * tid) = *(const GAS f32x4*)(modv + 6 * D + 4 * tid); *(LAS f32x4*)(add + 4 * tid) = *(const GAS f32x4*)(modv + 8 * D + 4 * tid);
      if (tid < 48) rb[tid] = tid < NGRP ? a.b_rg[tid] : tid < NGRP + NE ? a.b_re[tid - NGRP] : 0.f; }
    __syncthreads();
    const float* X1 = a.out; bf16_t* H2 = (bf16_t*)(F.ws + WS_R1);
    int* tok_e = (int*)(F.ws + WS_TOKE); int* tok_p = (int*)(F.ws + WS_TOKP); int* rowidx = (int*)(F.ws + WS_ROWIDX); float* roww = (float*)(F.ws + WS_ROWW);
    unsigned* ecnt = F.ctl + CW_ECNT;
    const int wv = F.wave, tile = wv & 3, half = wv >> 2, r = lane & 15, kq = lane >> 4;
    for (int rbk = F.vcu; rbk < T / 64; rbk += F.G) {
        if (tid < 32) lcnt[tid] = 0u;
        const int m0 = rbk * 64 + tile * 16, b = m0 / SEQ, kb = half * 512 + 8 * kq;
        const float* xr = X1 + (size_t)(m0 + r) * D + kb;
        f32x4 xa[16], xb[16];
#pragma unroll
        for (int sx = 0; sx < 16; ++sx) { xa[sx] = *(const GAS f32x4*)(xr + 32 * sx); xb[sx] = *(const GAS f32x4*)(xr + 32 * sx + 4); }
        float ss = 0.f;
#pragma unroll
        for (int sx = 0; sx < 16; ++sx) ss += (xa[sx].x * xa[sx].x + xa[sx].y * xa[sx].y) + (xa[sx].z * xa[sx].z + xa[sx].w * xa[sx].w) + (xb[sx].x * xb[sx].x + xb[sx].y * xb[sx].y) + (xb[sx].z * xb[sx].z + xb[sx].w * xb[sx].w);
        ss += __shfl_xor(ss, 16); ss += __shfl_xor(ss, 32);
        if (kq == 0) ssq[wv * 16 + r] = ss;
        __syncthreads();
        const float rstd = 1.f / sqrtf((ssq[wv * 16 + r] + ssq[(wv ^ 4) * 16 + r]) * (1.f / D) + NORM_EPS);
        f32x4 acc[3] = {{0.f, 0.f, 0.f, 0.f}, {0.f, 0.f, 0.f, 0.f}, {0.f, 0.f, 0.f, 0.f}};
        bf16_t* hrow = H2 + (size_t)(m0 + r) * D + kb;
#pragma unroll
        for (int sx = 0; sx < 16; ++sx) { const int kk = kb + 32 * sx;
            const f32x4 ml = *(const LAS f32x4*)(mul + b * D + kk), mh = *(const LAS f32x4*)(mul + b * D + kk + 4), al = *(const LAS f32x4*)(add + b * D + kk), ah = *(const LAS f32x4*)(add + b * D + kk + 4);
            const f32x4 hl = xa[sx] * rstd * ml + al, hh = xb[sx] * rstd * mh + ah;
            u32x4 hw; hw.x = cvt_pk_bf16(hl.x, hl.y); hw.y = cvt_pk_bf16(hl.z, hl.w); hw.z = cvt_pk_bf16(hh.x, hh.y); hw.w = cvt_pk_bf16(hh.z, hh.w);
            *(GAS u32x4*)(hrow + 32 * sx) = hw;
            const bf16x8 hf = __builtin_bit_cast(bf16x8, hw);
#pragma unroll
            for (int nt = 0; nt < 3; ++nt) { const bf16x8 wf = *(const LAS bf16x8*)(wrl + ((16 * nt + r) * 1032 + kk) * 2); acc[nt] = __builtin_amdgcn_mfma_f32_16x16x32_bf16(hf, wf, acc[nt], 0, 0, 0); } }
#pragma unroll
        for (int nt = 0; nt < 3; ++nt)
#pragma unroll
            for (int j = 0; j < 4; ++j) lgx[(wv * 16 + 4 * kq + j) * 48 + 16 * nt + r] = acc[nt][j];
        __syncthreads();
        if (tid < 64) {
            const int tl = tid >> 4, rw = tid & 15; float lg[36];
#pragma unroll
            for (int c4 = 0; c4 < 9; ++c4) { const f32x4 p = *(const LAS f32x4*)(lgx + (tl * 16 + rw) * 48 + 4 * c4), q = *(const LAS f32x4*)(lgx + ((tl + 4) * 16 + rw) * 48 + 4 * c4), bz = *(const LAS f32x4*)(rb + 4 * c4);
                lg[4 * c4] = p.x + q.x + bz.x; lg[4 * c4 + 1] = p.y + q.y + bz.y; lg[4 * c4 + 2] = p.z + q.z + bz.z; lg[4 * c4 + 3] = p.w + q.w + bz.w; }
            int gs = 0; float gm = lg[0];
#pragma unroll
            for (int g = 1; g < 4; ++g) if (lg[g] > gm) { gm = lg[g]; gs = g; }
            float gden = 0.f;
#pragma unroll
            for (int g = 0; g < 4; ++g) gden += __expf(lg[g] - gm);
            const float g_w = 1.f / gden;
            float el[8];
#pragma unroll
            for (int j = 0; j < 8; ++j) el[j] = gs == 0 ? lg[4 + j] : gs == 1 ? lg[12 + j] : gs == 2 ? lg[20 + j] : lg[28 + j];
            int i0 = 0; float m0v = el[0];
#pragma unroll
            for (int j = 1; j < 8; ++j) if (el[j] > m0v) { m0v = el[j]; i0 = j; }
            int i1 = -1; float m1v = -3e38f;
#pragma unroll
            for (int j = 0; j < 8; ++j) if (j != i0 && el[j] > m1v) { m1v = el[j]; i1 = j; }
            const float e1 = __expf(m1v - m0v), w0 = g_w / (1.f + e1), w1 = g_w * e1 / (1.f + e1);
            asg_e[tid * 2] = gs * 8 + i0; asg_e[tid * 2 + 1] = gs * 8 + i1; asg_w[tid * 2] = w0; asg_w[tid * 2 + 1] = w1;
        }
        __syncthreads();
        if (tid < 128) asg_p[tid] = __hip_atomic_fetch_add(&lcnt[asg_e[tid]], 1u, __ATOMIC_RELAXED, __HIP_MEMORY_SCOPE_WORKGROUP);
        __syncthreads();
        if (tid < 32) { const unsigned c = lcnt[tid]; lbase[tid] = c ? atomicAdd(&ecnt[tid], c) : 0u; }
        __syncthreads();
        if (tid < 128) { const int m = rbk * 64 + (tid >> 1), e = asg_e[tid]; const int pos = (int)(lbase[e] + asg_p[tid]);
            tok_e[m * 2 + (tid & 1)] = e; tok_p[m * 2 + (tid & 1)] = pos; rowidx[(size_t)e * ECAP + pos] = m; roww[(size_t)e * ECAP + pos] = asg_w[tid]; }
        __syncthreads();
    }
}

struct MoeOrder {
    const LAS int* tpre;
    const LAS int* cnts;
    const LAS int* rowtab;
    const char* A; const char* B; size_t a_tile_bytes, b_exp_bytes, b_tile_bytes; int G, c, nunits;
    __device__ bool next(int i, pg8::Unit& u) const {
        const long L = (long)i * G + c; if (L >= nunits) return false;
        int wgid = (int)L; { const int q = nunits / 8, r = nunits % 8, xcd = wgid % 8, off = wgid / 8; wgid = (xcd < r ? xcd * (q + 1) : r * (q + 1) + (xcd - r) * q) + off; }
        const int ti = wgid >> 2; u.pn = wgid & 3; u.pm = ti;
        int e = 0;
#pragma unroll 1
        for (int s = 16; s >= 1; s >>= 1) if (tpre[e + s] <= ti) e += s;
        u.e = e; const int r0 = (ti - tpre[e]) * 256; u.nvalid = cnts[e] - r0 < 256 ? cnts[e] - r0 : 256;
        u.A = A + (size_t)ti * a_tile_bytes; u.B = B + (size_t)e * b_exp_bytes + (size_t)u.pn * b_tile_bytes; return true;
    }
    __device__ __forceinline__ unsigned arow(int i, int r) const { return (unsigned)rowtab[(i & 7) * 256 + r]; }
};
__device__ __forceinline__ int moe_setup(Frame& F, LAS int* tpre, LAS int* cnts) {
    const unsigned* ecnt = F.ctl + CW_ECNT;
    if (F.tid == 0) { int acc = 0; for (int e = 0; e < NE; ++e) { const int c = (int)ecnt[e]; cnts[e] = c; tpre[e] = acc; acc += (c + 255) >> 8; } tpre[NE] = acc; }
    __syncthreads();
    return tpre[NE];
}
struct EpiSwiglu {
    static constexpr bool PERM = true;
    bf16_t* ACT;
    __device__ __forceinline__ void operator()(const f32x4 (&acc)[2][2][4][2], const pg8::Unit& u, int wr, int wc, int fr, int fq) const {
        const int row0 = u.pm * 256 + wr * 64 + fr, ch0 = u.pn * 128 + wc * 32 + 8 * fq;
#pragma unroll
        for (int ai = 0; ai < 2; ++ai)
#pragma unroll
            for (int m = 0; m < 4; ++m) { const f32x4 g0 = acc[ai][0][m][0], g1 = acc[ai][0][m][1], u0 = acc[ai][1][m][0], u1 = acc[ai][1][m][1];
                u32x4 w; w.x = cvt_pk_bf16(silu_(g0[0]) * u0[0], silu_(g0[1]) * u0[1]); w.y = cvt_pk_bf16(silu_(g0[2]) * u0[2], silu_(g0[3]) * u0[3]);
                w.z = cvt_pk_bf16(silu_(g1[0]) * u1[0], silu_(g1[1]) * u1[1]); w.w = cvt_pk_bf16(silu_(g1[2]) * u1[2], silu_(g1[3]) * u1[3]);
                *(GAS u32x4*)(ACT + (size_t)(row0 + ai * 128 + m * 16) * 512 + ch0) = w; }
    }
};
struct EpiDown {
    static constexpr bool PERM = true;
    bf16_t* CT; const float* roww; const LAS int* tpre;
    __device__ __forceinline__ void operator()(const f32x4 (&acc)[2][2][4][2], const pg8::Unit& u, int wr, int wc, int fr, int fq) const {
        const int lr0 = wr * 64 + fr, col0 = u.pn * 256 + wc * 32 + 8 * fq; const int pos0 = (u.pm - tpre[u.e]) * 256;
#pragma unroll
        for (int ai = 0; ai < 2; ++ai)
#pragma unroll
            for (int m = 0; m < 4; ++m) { const int lr = lr0 + ai * 128 + m * 16; const float wt = lr < u.nvalid ? roww[(size_t)u.e * ECAP + pos0 + lr] : 0.f;
#pragma unroll
                for (int bj = 0; bj < 2; ++bj) { const f32x4 v0 = acc[ai][bj][m][0] * wt, v1 = acc[ai][bj][m][1] * wt;
                    u32x4 w; w.x = cvt_pk_bf16(v0[0], v0[1]); w.y = cvt_pk_bf16(v0[2], v0[3]); w.z = cvt_pk_bf16(v1[0], v1[1]); w.w = cvt_pk_bf16(v1[2], v1[3]);
                    *(GAS u32x4*)(CT + (size_t)(u.pm * 256 + lr) * 1024 + col0 + bj * 128) = w; } }
    }
};

__device__ __forceinline__ void p12_final(Frame& F, const Args& a) {
    LAS int* tpre = (LAS int*)(F.lds + 0); LAS int* cnts = tpre + 64;
    moe_setup(F, tpre, cnts);
    LAS float* g2 = (LAS float*)(F.lds + 1024);
    LAS float* fg = g2 + 2 * D;
    const float* modv = (const float*)(F.ws + WS_MODV);
    *(LAS f32x4*)(g2 + 4 * F.tid) = *(const GAS f32x4*)(modv + 10 * D + 4 * F.tid);
    if (F.tid < D / 4) *(LAS f32x4*)(fg + 4 * F.tid) = *(const GAS f32x4*)(a.final_g + 4 * F.tid);
    __syncthreads();
    const int* tok_e = (const int*)(F.ws + WS_TOKE); const int* tok_p = (const int*)(F.ws + WS_TOKP); const bf16_t* CT = (const bf16_t*)(F.ws + WS_CONTRIB);
    const int gw = F.vcu * NWAVES + F.wave, NGW = F.G * NWAVES, lane = F.lane;
    for (int m = gw; m < T; m += 2 * NGW) {
        int mm[2]; mm[0] = m; mm[1] = (m + NGW < T) ? m + NGW : m;
        size_t r0[2], r1[2];
#pragma unroll
        for (int q = 0; q < 2; ++q) { const int e0 = tok_e[mm[q] * 2], e1 = tok_e[mm[q] * 2 + 1]; r0[q] = (size_t)(tpre[e0] * 256 + tok_p[mm[q] * 2]); r1[q] = (size_t)(tpre[e1] * 256 + tok_p[mm[q] * 2 + 1]); }
        f32x4 xv[2][4]; u32x2 pv[2][4], qv[2][4];
#pragma unroll
        for (int q = 0; q < 2; ++q) { const GAS f32x4* xr = (const GAS f32x4*)(a.out + (size_t)mm[q] * D) + lane;
            const GAS u32x2* c0 = (const GAS u32x2*)(CT + r0[q] * 1024) + lane; const GAS u32x2* c1 = (const GAS u32x2*)(CT + r1[q] * 1024) + lane;
#pragma unroll
            for (int j = 0; j < 4; ++j) { xv[q][j] = xr[64 * j]; pv[q][j] = c0[64 * j]; qv[q][j] = c1[64 * j]; } }
        f32x4 v[2][4]; float sv[2] = {0.f, 0.f};
#pragma unroll
        for (int q = 0; q < 2; ++q) { const int b = mm[q] / SEQ;
#pragma unroll
            for (int j = 0; j < 4; ++j) { const u32x2 p = pv[q][j], qq = qv[q][j]; const f32x4 g = *(const LAS f32x4*)(g2 + b * D + 256 * j + 4 * lane);
                f32x4 y; y.x = bf_lo(p.x) + bf_lo(qq.x); y.y = bf_hi(p.x) + bf_hi(qq.x); y.z = bf_lo(p.y) + bf_lo(qq.y); y.w = bf_hi(p.y) + bf_hi(qq.y);
                v[q][j] = xv[q][j] + g * y; sv[q] += (v[q][j].x * v[q][j].x + v[q][j].y * v[q][j].y) + (v[q][j].z * v[q][j].z + v[q][j].w * v[q][j].w); } }
#pragma unroll
        for (int o = 1; o < 64; o <<= 1) { sv[0] += __shfl_xor(sv[0], o); sv[1] += __shfl_xor(sv[1], o); }
#pragma unroll
        for (int q = 0; q < 2; ++q) if (q == 0 || mm[1] != mm[0]) { const float rstd = 1.f / sqrtf(sv[q] * (1.f / D) + NORM_EPS);
            GAS f32x4* orow = (GAS f32x4*)(a.out + (size_t)mm[q] * D) + lane;
#pragma unroll
            for (int j = 0; j < 4; ++j) orow[64 * j] = v[q][j] * rstd * *(const LAS f32x4*)(fg + 256 * j + 4 * lane); }
    }
}

__global__ void __launch_bounds__(NTHR, 2) mk_fwd(Args args) {
    extern __shared__ __attribute__((aligned(16))) unsigned char lds_raw[];
    Frame F;
    F.lds = (LAS unsigned char*)lds_raw; F.MISC = (volatile LAS unsigned*)(F.lds + MISC_OFF);
    F.tid = threadIdx.x; F.lane = F.tid & 63; F.wave = __builtin_amdgcn_readfirstlane(F.tid >> 6);
    F.G = gridDim.x; { const int bx = blockIdx.x; F.vcu = (F.G % 8 == 0) ? (bx % 8) * (F.G / 8) + bx / 8 : bx; }
    F.ws = args.ws; F.ctl = (unsigned*)(args.ws + WS_CTL);
    if (F.tid < 64) F.MISC[F.tid] = 0u;
    __syncthreads();
    XcdBarrier bar; bar.bar = F.ctl + CW_BAR; bar.x = 0; bar.st = nullptr;
    if (N_LAUNCHES == 1) bar = xcd_barrier_post(F.ctl + CW_BAR, F.MISC + 8);
    const int lo = args.ph_lo, hi = args.ph_hi;
#define IN(k) (lo <= (k) && (k) < hi)
#define SEAM(k) do { if (IN(k) && IN((k) + 1)) xcd_barrier(bar); } while (0)
    unsigned char* ws = args.ws;

#ifndef PROBE_PH
#define PROBE_PH (-1)
#endif
#define REPS(k) for (int rep_ = 0; rep_ < ((PROBE_PH) == (k) ? 2 : 1); ++rep_)
#define REPBAR(k) do { if ((PROBE_PH) == (k) && rep_ == 0) xcd_barrier(bar); } while (0)
    if (IN(0)) REPS(0) { p0_prologue(F, args); REPBAR(0); } SEAM(0);
    if (IN(1)) { p1_finalize(F, args); } SEAM(1);
    if (IN(2)) REPS(2) { p2_h1_rows(F, args); REPBAR(2); } SEAM(2);
    if (IN(3)) {
        pg8::StaticOrder S; S.init(ws + WS_R1, ws + WS_WIN, T, DIN, D, F.G, (int)blockIdx.x);
        EpiInProj E{(bf16_t*)(ws + WS_Q), (bf16_t*)(ws + WS_K), (bf16_t*)(ws + WS_V), (bf16_t*)(ws + WS_U), (bf16_t*)(ws + WS_BG), (bf16_t*)args.out, (bf16_t*)args.out + (size_t)T * D, args.b_gate};
        pg8::gemm_phase<EpiInProj, pg8::StaticOrder, true, false>(F.lds, D, S, E);
    } SEAM(3);
    if (IN(4)) REPS(4) { p3_kmean(F); REPBAR(4); } SEAM(4);
    if (IN(5)) { p4_topk(F); } SEAM(5);
    if (IN(6)) REPS(6) { p5_attention(F, args); REPBAR(6); } SEAM(6);
    if (IN(7)) REPS(7) { p6_combine_conv(F, args); REPBAR(7); } SEAM(7);
    if (IN(8)) {
        { pg8::StaticOrder S; S.init(ws + WS_R1, ws + WS_WAO, T, D, AW, F.G, (int)blockIdx.x);
          EpiGate<false> E{(bf16_t*)(ws + WS_MERGED), (const bf16_t*)args.out};
          pg8::gemm_phase<EpiGate<false>, pg8::StaticOrder, false, false>(F.lds, AW, S, E); }
        VM_WAIT(); __syncthreads();
        { pg8::StaticOrder S; S.init(ws + WS_R1 + (size_t)T * 512 * 2, ws + WS_WCO, T, D, CWD, F.G, (int)blockIdx.x);
          EpiGate<true> E{(bf16_t*)(ws + WS_MERGED), (const bf16_t*)args.out + (size_t)T * D};
          pg8::gemm_phase<EpiGate<true>, pg8::StaticOrder, false, false>(F.lds, CWD, S, E); }
    } SEAM(8);
    if (IN(9)) {
        pg8::StaticOrder S; S.init(ws + WS_MERGED, ws + WS_WO, T, D, D, F.G, (int)blockIdx.x);
        EpiResid E{args.x, args.out, (const float*)(ws + WS_MODV) + 4 * D};
        pg8::gemm_phase<EpiResid, pg8::StaticOrder, false, false>(F.lds, D, S, E);
    } SEAM(9);
    if (IN(10)) { p9_norm_route(F, args); } SEAM(10);
    if (IN(11)) {
        LAS int* tpre = (LAS int*)(F.lds + MISC_OFF + 256); LAS int* cnts = tpre + 64; LAS int* rowtab = (LAS int*)(F.lds + ROWTAB_OFF);
        const int ntiles = moe_setup(F, tpre, cnts);
        MoeOrder S{tpre, cnts, rowtab, (const char*)(ws + WS_R1), (const char*)(ws + WS_WGU), 0, (size_t)1024 * 1024 * 2, (size_t)256 * 1024 * 2, F.G, (int)blockIdx.x, ntiles * 4};
        { pg8::Unit u; const int* rowidx = (const int*)(ws + WS_ROWIDX);
          for (int i = 0; i < 8 && S.next(i, u); ++i) { if (F.tid < 256) { const int r0 = (u.pm - tpre[u.e]) * 256; rowtab[i * 256 + F.tid] = F.tid < u.nvalid ? rowidx[(size_t)u.e * ECAP + r0 + F.tid] : rowidx[(size_t)u.e * ECAP + r0]; } } }
        __syncthreads();
        EpiSwiglu E{(bf16_t*)(ws + WS_ACT)};
        pg8::gemm_phase<EpiSwiglu, MoeOrder, true, true>(F.lds, D, S, E);
    } SEAM(11);
    if (IN(12)) {
        LAS int* tpre = (LAS int*)(F.lds + MISC_OFF + 256); LAS int* cnts = tpre + 64;
        const int ntiles = moe_setup(F, tpre, cnts);
        MoeOrder S{tpre, cnts, nullptr, (const char*)(ws + WS_ACT), (const char*)(ws + WS_WD), (size_t)256 * 512 * 2, (size_t)1024 * 512 * 2, (size_t)256 * 512 * 2, F.G, (int)blockIdx.x, ntiles * 4};
        EpiDown E{(bf16_t*)(ws + WS_CONTRIB), (const float*)(ws + WS_ROWW), tpre};
        pg8::gemm_phase<EpiDown, MoeOrder, true, false>(F.lds, DE, S, E);
    } SEAM(12);
    if (IN(13)) { p12_final(F, args); }
#undef REPS
#undef REPBAR
#undef IN
#undef SEAM
}

extern "C" void kernel_launch(void* const* d_in, const int* in_sizes, int n_in, void* d_out, int out_size, void* d_ws, size_t ws_size, hipStream_t stream) {
    static int grid = 0;
    if (grid == 0) {
        if (n_in != 21 || in_sizes[0] != T * D || out_size != T * D || ws_size < WS_END) { fprintf(stderr, "kernel_launch: unexpected shapes (n_in %d, in0 %d, out %d, ws %zu < %zu)\n", n_in, n_in > 0 ? in_sizes[0] : -1, out_size, ws_size, (size_t)WS_END); grid = -1; return; }
        int dev = 0, cus = 0, per_cu = 0;
        if (hipGetDevice(&dev) != hipSuccess || hipDeviceGetAttribute(&cus, hipDeviceAttributeMultiprocessorCount, dev) != hipSuccess) { grid = -1; return; }
        if (hipFuncSetAttribute((const void*)mk_fwd, hipFuncAttributeMaxDynamicSharedMemorySize, LDS_BYTES) != hipSuccess) { fprintf(stderr, "kernel_launch: hipFuncSetAttribute failed\n"); grid = -1; return; }
        if (hipOccupancyMaxActiveBlocksPerMultiprocessor(&per_cu, (const void*)mk_fwd, NTHR, LDS_BYTES) != hipSuccess || per_cu < 1) fprintf(stderr, "kernel_launch: occupancy query reports %d\n", per_cu);
        (void)hipGetLastError();
        grid = cus;
    }
    if (grid < 0) return;
    if (hipMemsetAsync((char*)d_ws + WS_CTL, 0, CTL_ZERO_BYTES, stream) != hipSuccess) return;
    Args a{};
    const float** ap = (const float**)&a;
    for (int i = 0; i < 21; ++i) ap[i] = (const float*)d_in[i];
    a.out = (float*)d_out; a.ws = (unsigned char*)d_ws;
    for (int li = 0; li < N_LAUNCHES; ++li) {
        a.ph_lo = (N_LAUNCHES == 1) ? 0 : li; a.ph_hi = (N_LAUNCHES == 1) ? N_PHASES : li + 1;
        hipLaunchKernelGGL(mk_fwd, dim3(grid), dim3(NTHR), LDS_BYTES, stream, a);
        if (hipPeekAtLastError() != hipSuccess) { fprintf(stderr, "kernel_launch: launch %d failed\n", li); break; }
    }
}
```

```cpp
#include <hip/hip_runtime.h>
#include <cstdio>
#include <cstdint>
#define PROBE_PH (-1)

#define LAS __attribute__((address_space(3)))
#define GAS __attribute__((address_space(1)))
typedef unsigned short bf16_t;
typedef short bf16x8 __attribute__((ext_vector_type(8)));
typedef short s16x4 __attribute__((ext_vector_type(4)));
typedef float f32x4 __attribute__((ext_vector_type(4)));
typedef float f32x16 __attribute__((ext_vector_type(16)));
typedef float f32x2 __attribute__((ext_vector_type(2)));
typedef unsigned u32x4 __attribute__((ext_vector_type(4)));
typedef unsigned u32x2 __attribute__((ext_vector_type(2)));
typedef __bf16 bf16x2_t __attribute__((ext_vector_type(2)));

__device__ __forceinline__ unsigned cvt_pk_bf16(float lo, float hi) { f32x2 v = {lo, hi}; bf16x2_t b = __builtin_convertvector(v, bf16x2_t); return __builtin_bit_cast(unsigned, b); }
__device__ __forceinline__ float bf_lo(unsigned u) { return __builtin_bit_cast(float, u << 16); }
__device__ __forceinline__ float bf_hi(unsigned u) { return __builtin_bit_cast(float, u & 0xffff0000u); }
__device__ __forceinline__ float sigmoidf_(float x) { return __builtin_amdgcn_rcpf(1.f + __expf(-x)); }

namespace pg8 {
constexpr int BM = 256, BK = 64, HALF = 128, HTB = HALF * BK * 2, STAGE_BYTES = 8 * HTB, NXCD = 8, WGM = 8;
__host__ __device__ __forceinline__ int lds_byte(int r, int c) { const int st = (r >> 4) * 2 + (c >> 5), rr = r & 15, cc = c & 31, ob = rr * 64 + cc * 2; return st * 1024 + (ob ^ (((ob >> 9) & 1) << 5)); }
__host__ __device__ __forceinline__ void stage_rc(int b, int& R, int& C) { const int st = b / 1024, sb = b % 1024, swz = sb ^ (((sb >> 9) & 1) << 5); R = (st >> 1) * 16 + swz / 64; C = (st & 1) * 32 + (swz % 64) / 2; }
__host__ __device__ __forceinline__ int perm32(int rho) { const int n = rho >> 4, i = rho & 15; return 8 * (i >> 2) + 4 * n + (i & 3); }

struct Unit { const char* A; const char* B; int pm, pn, e, nvalid; };

struct StaticOrder {
    const char* A; const char* Bt; int K; int nM, nN, nwg, G, c;
    __device__ void init(const void* A_, const void* Bt_, int M, int N, int K_, int G_, int c_) { A = (const char*)A_; Bt = (const char*)Bt_; K = K_; nM = M / BM; nN = N / BM; nwg = nM * nN; G = G_; c = c_; }
    __device__ bool next(int i, Unit& u) const {
        const long L = (long)i * G + c; if (L >= nwg) return false;
        int wgid = (int)L; { const int q = nwg / NXCD, r = nwg % NXCD, xcd = wgid % NXCD, off = wgid / NXCD; wgid = (xcd < r ? xcd * (q + 1) : r * (q + 1) + (xcd - r) * q) + off; }
        const int nig = WGM * nN, gid = wgid / nig, fm = gid * WGM, gsz = (nM - fm) < WGM ? (nM - fm) : WGM;
        u.pm = fm + ((wgid % nig) % gsz); u.pn = (wgid % nig) / gsz; u.e = 0; u.nvalid = 256;
        u.A = A + (size_t)u.pm * 256 * K * 2; u.B = Bt + (size_t)u.pn * 256 * K * 2; return true;
    }
    __device__ __forceinline__ unsigned arow(int, int) const { return 0u; }
};

template <class Epi, class Sched, bool ALIGN_EPI, bool GATHER, bool HALFSKIP = false, bool MIDHOOK = false>
__device__ __forceinline__ void gemm_phase(LAS unsigned char* lds, const int K, const Sched& S, const Epi& E) {
    const int tid = threadIdx.x, wid = __builtin_amdgcn_readfirstlane(tid >> 6), lane = tid & 63, wr = wid >> 2, wc = wid & 3, fr = lane & 15, fq = lane >> 4;
    const int nt = K / BK;
    unsigned voffB[2]; int RA[2], CA[2];
#pragma unroll
    for (int i = 0; i < 2; ++i) { int R, C; stage_rc(tid * 16 + i * 8192, R, C); const int Rb = Epi::PERM ? ((R & ~31) + perm32(R & 31)) : R;
        RA[i] = R; CA[i] = C; voffB[i] = (unsigned)(Rb * K + C) * 2u; }
    const size_t kstep = (size_t)(BK * 2);
    const size_t hstep = (size_t)HALF * K * 2;
    const unsigned ldsw = (unsigned)wid * 1024u;
    const int aoff = lds_byte(wr * 64 + fr, fq * 8), boff = lds_byte(wc * 32 + fr, fq * 8);
#define PG8_SA(b, h) (((b) * 2 + (h)) * HTB)
#define PG8_SB(b, h) ((4 + (b) * 2 + (h)) * HTB)
#define PG8_STAGE(bufoff, gbase, voff) do { _Pragma("unroll") for (int _i = 0; _i < 2; ++_i) \
        __builtin_amdgcn_global_load_lds((const unsigned*)((const char*)(gbase) + (voff)[_i]), (LAS unsigned*)(lds + (bufoff) + ldsw + _i * 8192), 16, 0, 0); } while (0)
#define PG8_LDA(dst, b, h) do { _Pragma("unroll") for (int m = 0; m < 4; ++m) _Pragma("unroll") for (int k = 0; k < 2; ++k) dst[m][k] = *(const LAS bf16x8*)(lds + PG8_SA(b, h) + aoff + m * 2048 + k * 1024); } while (0)
#define PG8_LDB(dst, b, h) do { _Pragma("unroll") for (int n = 0; n < 2; ++n) _Pragma("unroll") for (int k = 0; k < 2; ++k) dst[n][k] = *(const LAS bf16x8*)(lds + PG8_SB(b, h) + boff + n * 2048 + k * 1024); } while (0)
#define PG8_MMA(ai, bj, At, Bt) do { __builtin_amdgcn_s_setprio(1); _Pragma("unroll") for (int m = 0; m < 4; ++m) _Pragma("unroll") for (int n = 0; n < 2; ++n) _Pragma("unroll") for (int k = 0; k < 2; ++k) \
        acc[ai][bj][m][n] = __builtin_amdgcn_mfma_f32_16x16x32_bf16(Bt[n][k], At[m][k], acc[ai][bj][m][n], 0, 0, 0); __builtin_amdgcn_s_setprio(0); } while (0)
#define PG8_WAIT_V(n) asm volatile("s_waitcnt vmcnt(" #n ")" ::: "memory")
#define PG8_WAIT_L(n) asm volatile("s_waitcnt lgkmcnt(" #n ")" ::: "memory")
#define PG8_BAR __builtin_amdgcn_s_barrier()
#define PG8_SCHED __builtin_amdgcn_sched_barrier(0)
    Unit cur, nxt; int ui = 0;
    if (!S.next(0, cur)) return;
    f32x4 acc[2][2][4][2];
#pragma unroll
    for (int a = 0; a < 2; ++a)
#pragma unroll
        for (int b = 0; b < 2; ++b)
#pragma unroll
            for (int m = 0; m < 4; ++m)
#pragma unroll
                for (int n = 0; n < 2; ++n) acc[a][b][m][n] = (f32x4){0.f, 0.f, 0.f, 0.f};
    bf16x8 At[4][2], B0[2][2], B1[2][2];
    unsigned va[2][2], vn[2][2];
#pragma unroll
    for (int h = 0; h < 2; ++h)
#pragma unroll
        for (int i = 0; i < 2; ++i) {
            if constexpr (GATHER) va[h][i] = S.arow(0, h * HALF + RA[i]) * (unsigned)(K * 2) + (unsigned)(CA[i] * 2);
            else va[h][i] = (unsigned)((h * HALF + RA[i]) * K + CA[i]) * 2u;
            vn[h][i] = va[h][i]; }
    const char* cA = cur.A; const char* cB = cur.B;
    PG8_STAGE(PG8_SB(0, 0), cB, voffB); PG8_STAGE(PG8_SB(0, 1), cB + hstep, voffB); PG8_STAGE(PG8_SA(0, 0), cA, va[0]); PG8_STAGE(PG8_SA(0, 1), cA, va[1]);
    if (wr == 1) PG8_BAR;
    PG8_WAIT_V(2); PG8_BAR;
    PG8_STAGE(PG8_SB(1, 0), cB + kstep, voffB); PG8_STAGE(PG8_SA(1, 0), cA + kstep, va[0]); PG8_STAGE(PG8_SB(1, 1), cB + hstep + kstep, voffB);
    PG8_WAIT_V(6); PG8_BAR;
    for (;;) {
        const bool has_next = S.next(ui + 1, nxt);
        const char* nA = has_next ? nxt.A : cA; const char* nB = has_next ? nxt.B : cB;
        if constexpr (GATHER) { if (has_next) {
#pragma unroll
            for (int h = 0; h < 2; ++h)
#pragma unroll
                for (int i = 0; i < 2; ++i) vn[h][i] = S.arow(ui + 1, h * HALF + RA[i]) * (unsigned)(K * 2) + (unsigned)(CA[i] * 2); } }
        const bool full = cur.nvalid > HALF;
        for (int t = 0; t < nt; t += 2) {
            const bool last = (t == nt - 2);
            if constexpr (MIDHOOK) { if (t == nt / 2) E.mid(acc, cur, wr, wc, fr, fq); }
            const char* a1 = cA + (size_t)(t + 1) * kstep;
            const char* a2 = last ? nA : cA + (size_t)(t + 2) * kstep; const char* b2 = last ? nB : cB + (size_t)(t + 2) * kstep;
            const char* a3 = a2 + kstep; const char* b3 = b2 + kstep;
            unsigned w0[2], w1[2];
            if constexpr (GATHER) { w0[0] = last ? vn[0][0] : va[0][0]; w0[1] = last ? vn[0][1] : va[0][1]; w1[0] = last ? vn[1][0] : va[1][0]; w1[1] = last ? vn[1][1] : va[1][1]; }
            else { w0[0] = va[0][0]; w0[1] = va[0][1]; w1[0] = va[1][0]; w1[1] = va[1][1]; }
            PG8_LDB(B0, 0, 0); PG8_LDB(B1, 0, 1); PG8_SCHED; PG8_LDA(At, 0, 0); PG8_STAGE(PG8_SA(1, 1), a1, va[1]);
            PG8_WAIT_V(8); PG8_WAIT_L(0); PG8_BAR; PG8_MMA(0, 0, At, B0); PG8_MMA(0, 1, At, B1); PG8_BAR; PG8_SCHED;
            if (!HALFSKIP || full) PG8_LDA(At, 0, 1); PG8_STAGE(PG8_SB(0, 0), b2, voffB); PG8_STAGE(PG8_SB(0, 1), b2 + hstep, voffB); PG8_STAGE(PG8_SA(0, 0), a2, w0);
            PG8_WAIT_V(8); PG8_WAIT_L(0); PG8_BAR; if (!HALFSKIP || full) { PG8_MMA(1, 0, At, B0); PG8_MMA(1, 1, At, B1); } PG8_BAR; PG8_SCHED;
            PG8_LDB(B0, 1, 0); PG8_LDB(B1, 1, 1); PG8_SCHED; PG8_LDA(At, 1, 0); PG8_STAGE(PG8_SA(0, 1), a2, w1);
            PG8_WAIT_V(8); PG8_WAIT_L(0); PG8_BAR; PG8_MMA(0, 0, At, B0); PG8_MMA(0, 1, At, B1); PG8_BAR; PG8_SCHED;
            if (!HALFSKIP || full) PG8_LDA(At, 1, 1); PG8_STAGE(PG8_SB(1, 0), b3, voffB); PG8_STAGE(PG8_SB(1, 1), b3 + hstep, voffB); PG8_STAGE(PG8_SA(1, 0), a3, w0);
            PG8_WAIT_V(8); PG8_WAIT_L(0); PG8_BAR; if (!HALFSKIP || full) { PG8_MMA(1, 0, At, B0); PG8_MMA(1, 1, At, B1); } PG8_BAR; PG8_SCHED;
        }
        if constexpr (ALIGN_EPI) { if (wr == 0) PG8_BAR; }
        E(acc, cur, wr, wc, fr, fq);
        if (!has_next) break;
#pragma unroll
        for (int a = 0; a < 2; ++a)
#pragma unroll
            for (int b = 0; b < 2; ++b)
#pragma unroll
                for (int m = 0; m < 4; ++m)
#pragma unroll
                    for (int n = 0; n < 2; ++n) acc[a][b][m][n] = (f32x4){0.f, 0.f, 0.f, 0.f};
        cur = nxt; cA = nA; cB = nB; ++ui;
#pragma unroll
        for (int h = 0; h < 2; ++h)
#pragma unroll
            for (int i = 0; i < 2; ++i) va[h][i] = vn[h][i];
        if constexpr (ALIGN_EPI) { if (wr == 1) PG8_BAR; }
    }
    PG8_WAIT_V(0);
    if constexpr (!ALIGN_EPI) { if (wr == 0) PG8_BAR; }
    PG8_BAR;
#undef PG8_SA
#undef PG8_SB
#undef PG8_STAGE
#undef PG8_LDA
#undef PG8_LDB
#undef PG8_MMA
#undef PG8_WAIT_V
#undef PG8_WAIT_L
#undef PG8_BAR
#undef PG8_SCHED
}
}

constexpr int NWAVES = 8, NTHR = 512;
constexpr int BATCH = 2, SEQ = 8192, D = 1024, T = BATCH * SEQ;
constexpr int NH = 8, HD = 64, AW = 512, CWD = 512, DIN = 5120, MB = 256, NBLK = SEQ / MB  , TOPK = 3;
constexpr int NE = 32, NGRP = 4, EPG = 8, DE = 512, NMOD = 6;
constexpr float NORM_EPS = 1e-6f;
constexpr float LOG2E = 1.4426950408889634f;
constexpr float QSCALE = 0.125f * LOG2E;
constexpr int CAPQ = (NBLK - 1) * MB;
constexpr int ECAP = T;
constexpr int APAD_MAX = 2 * T + NE * 255;
constexpr int MOD_KS = 16;

#ifndef MK_N_LAUNCHES
#define MK_N_LAUNCHES 1
#endif
constexpr int N_PHASES = 14;
constexpr int N_LAUNCHES = MK_N_LAUNCHES;

constexpr size_t MiB = 1u << 20;
constexpr size_t WS_CTL = 0, CTL_ZERO_BYTES = 65536;
constexpr size_t WS_MODPART = 1 * MiB;
constexpr size_t WS_MODV = 2 * MiB;
constexpr size_t WS_WRT = 2 * MiB + 768 * 1024;
constexpr size_t WS_KMEAN = 2 * MiB + 256 * 1024;
constexpr size_t WS_KMAX = 2 * MiB + 384 * 1024;
constexpr size_t WS_QN = 24 * MiB + 512 * 1024;
constexpr size_t WS_TOKE = 2 * MiB + 512 * 1024;
constexpr size_t WS_TOKP = WS_TOKE + 128 * 1024;
constexpr size_t WS_ROWIDX = 3 * MiB;
constexpr size_t WS_ROWW = 5 * MiB;
constexpr size_t WS_ML = 7 * MiB;
constexpr size_t WS_LIST = 9 * MiB;
constexpr size_t WS_WIN = 25 * MiB, WS_WAO = 35 * MiB, WS_WO = 37 * MiB;
constexpr size_t WS_OPART = 39 * MiB;
constexpr size_t WS_WGU = 39 * MiB, WS_WD = 103 * MiB;
constexpr size_t WS_R1 = 135 * MiB;
constexpr size_t WS_Q = 167 * MiB, WS_K = 183 * MiB, WS_V = 199 * MiB;
constexpr size_t WS_MERGED = 167 * MiB;
constexpr size_t WS_U = 215 * MiB, WS_BG = 231 * MiB;
constexpr size_t WS_CONTRIB = 167 * MiB;
constexpr size_t WS_ACT = 247 * MiB;
constexpr size_t WS_END = 287 * MiB;
static_assert(WS_CONTRIB + (size_t)APAD_MAX * 1024 * 2 <= WS_ACT && WS_ACT + (size_t)APAD_MAX * 512 * 2 <= WS_END, "ws map");
static_assert(WS_LIST + (size_t)512 * CAPQ * 4 <= WS_WIN, "ws map lists");
constexpr int CW_TMO = 0;
constexpr int CW_BAR = 4096;
constexpr int CW_QCNT = 8192;
constexpr int CW_ECNT = 9216;
constexpr int RING_BYTES = 131072;
constexpr int ROWTAB_OFF = 131072;
constexpr int MOETAB_OFF = 139264;
constexpr int LDS_BYTES = 163840;
constexpr int MISC_OFF = LDS_BYTES - 1024;

#define LDS_WAIT() asm volatile("s_waitcnt lgkmcnt(0)" ::: "memory")
#define VM_WAIT() asm volatile("s_waitcnt vmcnt(0)" ::: "memory")

#define XB_TMO      128
#define XB_XCNT(j)  (256  + 64 * (j))
#define XB_XSUB(j)  (1280 + 64 * (j))
#define XB_XGEN(j)  (2304 + 64 * (j))
#define XB_TOP      3328
#define XB_TOPGEN   3392
#define XCD_BAR_WORDS 3456
#define XB_SPIN_CAP (1u << 18)
__device__ __forceinline__ unsigned xb_ld(unsigned* p)              { return __hip_atomic_load(p, __ATOMIC_RELAXED, __HIP_MEMORY_SCOPE_AGENT); }
__device__ __forceinline__ unsigned xb_add(unsigned* p, unsigned v) { return __hip_atomic_fetch_add(p, v, __ATOMIC_RELAXED, __HIP_MEMORY_SCOPE_AGENT); }
__device__ __forceinline__ unsigned xb_xcc_id() { return (unsigned)__builtin_amdgcn_s_getreg((3 << 11) | 20) & 0xFu; }
#define XB_SPIN(cond, bar) do { unsigned _sp = 0; while (cond) { __builtin_amdgcn_s_sleep(1); \
    if ((++_sp & 255u) == 0u) { if (xb_ld(&(bar)[XB_TMO])) break; if (_sp > XB_SPIN_CAP) { atomicAdd(&(bar)[XB_TMO], 1u); break; } } } } while (0)
struct XcdBarrier { unsigned* bar; unsigned x; volatile LAS unsigned* st; };
__device__ __forceinline__ XcdBarrier xcd_barrier_post(unsigned* bar, volatile LAS unsigned* st) {
    XcdBarrier b; b.bar = bar; b.x = xb_xcc_id(); b.st = st;
    if (threadIdx.x == 0) (void)xb_add(&bar[XB_XCNT(b.x)], 1u);
    return b;
}
__device__ __forceinline__ void xcd_barrier_complete(unsigned* bar, unsigned x, unsigned& nloc, unsigned& nx) {
    const unsigned G = gridDim.x * gridDim.y * gridDim.z;
    unsigned sum, cnt, mine, sp = 0u;
    for (;;) {
        sum = 0u; cnt = 0u; mine = 0u;
#pragma unroll
        for (unsigned j = 0; j < 16; ++j) { const unsigned c = xb_ld(&bar[XB_XCNT(j)]); sum += c; cnt += (c > 0u) ? 1u : 0u; mine = (j == x) ? c : mine; }
        if (sum == G) break;
        __builtin_amdgcn_s_sleep(1);
        if ((++sp & 255u) == 0u) { if (xb_ld(&bar[XB_TMO])) break; if (sp > XB_SPIN_CAP) { atomicAdd(&bar[XB_TMO], 1u); break; } }
    }
    nloc = mine > 0u ? mine : 1u; nx = cnt > 0u ? cnt : 1u;
}
__device__ __forceinline__ void xcd_barrier(const XcdBarrier& b) {
    asm volatile("s_waitcnt vmcnt(0)" ::: "memory");
    __syncthreads();
    if (threadIdx.x == 0) {
        unsigned* bar = b.bar;
        __builtin_amdgcn_s_waitcnt(0);
        unsigned nloc = b.st[0], nx = b.st[1];
        if (nloc == 0u) { xcd_barrier_complete(bar, b.x, nloc, nx); b.st[0] = nloc; b.st[1] = nx; }
        const unsigned old = xb_add(&bar[XB_XSUB(b.x)], 1u);
        const unsigned gen = old / nloc;
        if (old + 1u == (gen + 1u) * nloc) {
            __builtin_amdgcn_fence(__ATOMIC_RELEASE, "agent");
            asm volatile("s_waitcnt vmcnt(0)" ::: "memory");
            const unsigned og = xb_add(&bar[XB_TOP], 1u);
            const unsigned tg = og / nx;
            if (og + 1u == (tg + 1u) * nx) xb_add(&bar[XB_TOPGEN], 1u);
            else XB_SPIN(xb_ld(&bar[XB_TOPGEN]) == tg, bar);
            __builtin_amdgcn_fence(__ATOMIC_ACQUIRE, "agent");
            xb_add(&bar[XB_XGEN(b.x)], 1u);
            asm volatile("s_waitcnt vmcnt(0)" ::: "memory");
        } else {
            XB_SPIN(xb_ld(&bar[XB_XGEN(b.x)]) == gen, bar);
            __builtin_amdgcn_fence(__ATOMIC_ACQUIRE, "agent");
            asm volatile("s_waitcnt vmcnt(0)" ::: "memory");
        }
    }
    __syncthreads();
}

struct Args {
    const float *x, *c, *rel_bias, *norm1_g, *norm2_g, *w_ada, *b_ada, *w_in, *b_gate, *conv_w, *w_attn_out, *w_conv_out, *w_o,
                *w_rg, *b_rg, *w_re, *b_re, *w_eg, *w_eu, *w_ed, *final_g;
    float* out; unsigned char* ws; int ph_lo, ph_hi;
};
struct Frame {
    LAS unsigned char* lds; volatile LAS unsigned* MISC; unsigned* ctl; unsigned char* ws;
    int tid, lane, wave, G, vcu;
};
__device__ __forceinline__ float wave_sum(float v) {
#pragma unroll
    for (int o = 1; o < 64; o <<= 1) v += __shfl_xor(v, o);
    return v;
}
__device__ __forceinline__ float silu_(float v) { return v * sigmoidf_(v); }

__device__ __forceinline__ void transpose_item(const float* W, int K, int N, bf16_t* WT, int k0, int n0, int drow0, LAS float* scr, int lane, int dpitch = 0, int dk0 = 0) {
    if (dpitch == 0) dpitch = K;
#pragma unroll 8
    for (int i = 0; i < 32; ++i) { const int kk = 2 * i + (lane >> 5); scr[kk * 33 + (lane & 31)] = W[(size_t)(k0 + kk) * N + n0 + (lane & 31)]; }
    LDS_WAIT(); asm volatile("" ::: "memory");
    const int c = lane & 7;
#pragma unroll
    for (int j = 0; j < 4; ++j) { const int n = (lane >> 3) + 8 * j; const LAS float* s = scr + (8 * c) * 33 + n;
        u32x4 o; o.x = cvt_pk_bf16(s[0 * 33], s[1 * 33]); o.y = cvt_pk_bf16(s[2 * 33], s[3 * 33]); o.z = cvt_pk_bf16(s[4 * 33], s[5 * 33]); o.w = cvt_pk_bf16(s[6 * 33], s[7 * 33]);
        *(GAS u32x4*)(WT + (size_t)(drow0 + n) * dpitch + dk0 + k0 + 8 * c) = o; }
    LDS_WAIT(); asm volatile("" ::: "memory");
}

__device__ __forceinline__ int win_dest_row(int n0) {
    if (n0 < 1536) return n0;
    if (n0 < 2048) { const int ch = n0 - 1536; return 256 * (6 + (ch >> 7)) + (ch & 127); }
    if (n0 < 2560) return 2560 + (n0 - 2048);
    if (n0 < 3072) { const int ch = n0 - 2560; return 256 * (6 + (ch >> 7)) + 128 + (ch & 127); }
    return n0;
}
__device__ __forceinline__ void p0_prologue(Frame& F, const Args& a) {
    LAS float* cact = (LAS float*)F.lds;
    for (int i = F.tid; i < 2 * D; i += NTHR) cact[i] = silu_(a.c[i]);
    __syncthreads();
    float* modpart = (float*)(F.ws + WS_MODPART);
    const int gw = F.vcu * NWAVES + F.wave, NGW = F.G * NWAVES, lane = F.lane;
    constexpr int NCG = (NMOD * D) / 64, KSL = D / MOD_KS;
    for (int it = gw; it < NCG * MOD_KS; it += NGW) {
        const int cg = it % NCG, ks = it / NCG, col = cg * 64 + (lane & 15) * 4, kr = lane >> 4;
        f32x4 a0 = {0.f, 0.f, 0.f, 0.f}, a1 = {0.f, 0.f, 0.f, 0.f};
#pragma unroll
        for (int i = 0; i < KSL / 4; ++i) { const int k = ks * KSL + 4 * i + kr; const f32x4 w = *(const GAS f32x4*)(a.w_ada + (size_t)k * (NMOD * D) + col); a0 += w * cact[k]; a1 += w * cact[D + k]; }
#pragma unroll
        for (int c = 0; c < 4; ++c) { a0[c] += __shfl_xor(a0[c], 16); a0[c] += __shfl_xor(a0[c], 32); a1[c] += __shfl_xor(a1[c], 16); a1[c] += __shfl_xor(a1[c], 32); }
        if (kr == 0) { *(GAS f32x4*)(modpart + (size_t)(ks * 2 + 0) * (NMOD * D) + col) = a0; *(GAS f32x4*)(modpart + (size_t)(ks * 2 + 1) * (NMOD * D) + col) = a1; }
    }
    LAS float* scr = (LAS float*)(F.lds + 16384 + F.wave * 8704);
    constexpr int I_IN = (D / 64) * (DIN / 32), I_AO = (AW / 64) * (D / 32), I_CO = I_AO, I_O = (D / 64) * (D / 32);
    for (int it = gw; it < I_IN + I_AO + I_CO + I_O; it += NGW) {
        int r = it;
        if (r < I_IN) { const int nb = r % (DIN / 32), kb = r / (DIN / 32); transpose_item(a.w_in, D, DIN, (bf16_t*)(F.ws + WS_WIN), 64 * kb, 32 * nb, win_dest_row(32 * nb), scr, lane); continue; } r -= I_IN;
        if (r < I_AO) { const int nb = r % (D / 32), kb = r / (D / 32); transpose_item(a.w_attn_out, AW, D, (bf16_t*)(F.ws + WS_WAO), 64 * kb, 32 * nb, 32 * nb, scr, lane, D, 0); continue; } r -= I_AO;
        if (r < I_CO) { const int nb = r % (D / 32), kb = r / (D / 32); transpose_item(a.w_conv_out, CWD, D, (bf16_t*)(F.ws + WS_WAO), 64 * kb, 32 * nb, 32 * nb, scr, lane, D, AW); continue; } r -= I_CO;
        { const int nb = r % (D / 32), kb = r / (D / 32); transpose_item(a.w_o, D, D, (bf16_t*)(F.ws + WS_WO), 64 * kb, 32 * nb, 32 * nb, scr, lane); }
    }
    bf16_t* wrt = (bf16_t*)(F.ws + WS_WRT);
    for (int t = gw * 64 + lane; t < 48 * 128; t += NGW * 64) { const int kc = t / 48, c = t % 48; float v[8];
#pragma unroll
        for (int j = 0; j < 8; ++j) { const int k = kc * 8 + j; v[j] = c < NGRP ? a.w_rg[k * NGRP + c] : c < NGRP + NE ? a.w_re[k * NE + (c - NGRP)] : 0.f; }
        u32x4 o; o.x = cvt_pk_bf16(v[0], v[1]); o.y = cvt_pk_bf16(v[2], v[3]); o.z = cvt_pk_bf16(v[4], v[5]); o.w = cvt_pk_bf16(v[6], v[7]);
        *(GAS u32x4*)(wrt + (size_t)c * D + kc * 8) = o; }
}
__device__ __forceinline__ void p1_finalize(Frame& F, const Args& a) {
    const float* modpart = (const float*)(F.ws + WS_MODPART); float* modv = (float*)(F.ws + WS_MODV);
    for (int idx = F.tid * F.G + (int)blockIdx.x; idx < 2 * NMOD * D; idx += F.G * NTHR) {
        const int b = idx / (NMOD * D), j = idx % (NMOD * D), ch = j >> 10, k = j & 1023;
        float s = a.b_ada[j];
#pragma unroll
        for (int ks = 0; ks < MOD_KS; ++ks) s += modpart[(size_t)(ks * 2 + b) * (NMOD * D) + j];
        int v; float val = s;
        if (ch == 0) v = 1; else if (ch == 1) { v = 0; val = a.norm1_g[k] * (1.f + s); } else if (ch == 2) v = 2; else if (ch == 3) v = 4; else if (ch == 4) { v = 3; val = a.norm2_g[k] * (1.f + s); } else v = 5;
        modv[(size_t)(v * 2 + b) * D + k] = val;
    }
}
__device__ __forceinline__ void p2_h1_rows(Frame& F, const Args& a) {
    const float* modv = (const float*)(F.ws + WS_MODV);
    LAS float* mul = (LAS float*)F.lds; LAS float* add = mul + 2 * D;
    for (int i = F.tid; i < 2 * D / 4; i += NTHR) { *(LAS f32x4*)(mul + 4 * i) = *(const GAS f32x4*)(modv + 4 * i); *(LAS f32x4*)(add + 4 * i) = *(const GAS f32x4*)(modv + 2 * D + 4 * i); }
    __syncthreads();
    const int gw = F.vcu * NWAVES + F.wave, NGW = F.G * NWAVES, lane = F.lane;
    bf16_t* H1 = (bf16_t*)(F.ws + WS_R1);
    for (int m = gw; m < T; m += 2 * NGW) {
        const int m1 = (m + NGW < T) ? m + NGW : m;
        const GAS f32x4* xa = (const GAS f32x4*)(a.x + (size_t)m * D) + lane; const GAS f32x4* xb = (const GAS f32x4*)(a.x + (size_t)m1 * D) + lane;
        f32x4 va[4], vb[4]; float sa = 0.f, sb = 0.f;
#pragma unroll
        for (int j = 0; j < 4; ++j) { va[j] = xa[64 * j]; vb[j] = xb[64 * j]; }
#pragma unroll
        for (int j = 0; j < 4; ++j) { sa += (va[j].x * va[j].x + va[j].y * va[j].y) + (va[j].z * va[j].z + va[j].w * va[j].w); sb += (vb[j].x * vb[j].x + vb[j].y * vb[j].y) + (vb[j].z * vb[j].z + vb[j].w * vb[j].w); }
#pragma unroll
        for (int o = 1; o < 64; o <<= 1) { sa += __shfl_xor(sa, o); sb += __shfl_xor(sb, o); }
        const float ra = 1.f / sqrtf(sa * (1.f / D) + NORM_EPS), rb = 1.f / sqrtf(sb * (1.f / D) + NORM_EPS);
        const int ba = m / SEQ, bb = m1 / SEQ;
        GAS u32x2* oa = (GAS u32x2*)(H1 + (size_t)m * D) + lane; GAS u32x2* ob = (GAS u32x2*)(H1 + (size_t)m1 * D) + lane;
#pragma unroll
        for (int j = 0; j < 4; ++j) {
            const f32x4 ha = va[j] * ra * *(const LAS f32x4*)(mul + ba * D + 256 * j + 4 * lane) + *(const LAS f32x4*)(add + ba * D + 256 * j + 4 * lane);
            const f32x4 hb = vb[j] * rb * *(const LAS f32x4*)(mul + bb * D + 256 * j + 4 * lane) + *(const LAS f32x4*)(add + bb * D + 256 * j + 4 * lane);
            u32x2 o; o.x = cvt_pk_bf16(ha.x, ha.y); o.y = cvt_pk_bf16(ha.z, ha.w); oa[64 * j] = o;
            if (m1 != m) { u32x2 p; p.x = cvt_pk_bf16(hb.x, hb.y); p.y = cvt_pk_bf16(hb.z, hb.w); ob[64 * j] = p; } }
    }
}
struct EpiInProj {
    static constexpr bool PERM = true;
    bf16_t *Q, *Kb, *V, *U, *BG, *SA, *SC; const float* b_gate;
    __device__ __forceinline__ void operator()(const f32x4 (&acc)[2][2][4][2], const pg8::Unit& u, int wr, int wc, int fr, int fq) const {
        const int pn = u.pn, row0 = u.pm * 256 + wr * 64 + fr, colw = wc * 32 + 8 * fq;
        if (pn >= 6 && pn < 10) {
            const int ch0 = (pn - 6) * 128 + colw;
#pragma unroll
            for (int ai = 0; ai < 2; ++ai)
#pragma unroll
                for (int m = 0; m < 4; ++m) { const f32x4 v0 = acc[ai][0][m][0] * acc[ai][1][m][0], v1 = acc[ai][0][m][1] * acc[ai][1][m][1];
                    u32x4 w; w.x = cvt_pk_bf16(v0[0], v0[1]); w.y = cvt_pk_bf16(v0[2], v0[3]); w.z = cvt_pk_bf16(v1[0], v1[1]); w.w = cvt_pk_bf16(v1[2], v1[3]);
                    *(GAS u32x4*)(U + (size_t)(row0 + ai * 128 + m * 16) * 512 + ch0) = w; }
        } else if (pn >= 12) {
            bf16_t* dst = pn < 16 ? SA : SC; const int ct = (pn & 3) * 256, bt = (pn - 12) * 256;
#pragma unroll
            for (int bj = 0; bj < 2; ++bj) { const f32x4 b0 = *(const GAS f32x4*)(b_gate + bt + bj * 128 + colw), b1 = *(const GAS f32x4*)(b_gate + bt + bj * 128 + colw + 4);
#pragma unroll
                for (int ai = 0; ai < 2; ++ai)
#pragma unroll
                    for (int m = 0; m < 4; ++m) { const f32x4 v0 = acc[ai][bj][m][0] + b0, v1 = acc[ai][bj][m][1] + b1;
                        u32x4 w; w.x = cvt_pk_bf16(sigmoidf_(v0[0]), sigmoidf_(v0[1])); w.y = cvt_pk_bf16(sigmoidf_(v0[2]), sigmoidf_(v0[3]));
                        w.z = cvt_pk_bf16(sigmoidf_(v1[0]), sigmoidf_(v1[1])); w.w = cvt_pk_bf16(sigmoidf_(v1[2]), sigmoidf_(v1[3]));
                        *(GAS u32x4*)(dst + (size_t)(row0 + ai * 128 + m * 16) * 1024 + ct + bj * 128 + colw) = w; } }
        } else {
            bf16_t* dst = pn < 2 ? Q : pn < 4 ? Kb : pn < 6 ? V : BG; const float sc = pn < 2 ? QSCALE : 1.f; const int ct = (pn & 1) * 256;
#pragma unroll
            for (int ai = 0; ai < 2; ++ai)
#pragma unroll
                for (int m = 0; m < 4; ++m)
#pragma unroll
                    for (int bj = 0; bj < 2; ++bj) { const f32x4 v0 = acc[ai][bj][m][0] * sc, v1 = acc[ai][bj][m][1] * sc;
                        u32x4 w; w.x = cvt_pk_bf16(v0[0], v0[1]); w.y = cvt_pk_bf16(v0[2], v0[3]); w.z = cvt_pk_bf16(v1[0], v1[1]); w.w = cvt_pk_bf16(v1[2], v1[3]);
                        *(GAS u32x4*)(dst + (size_t)(row0 + ai * 128 + m * 16) * 512 + ct + bj * 128 + colw) = w; }
        }
    }
};

__device__ __forceinline__ void p3_kmean(Frame& F) {
    const bf16_t* Kb = (const bf16_t*)(F.ws + WS_K); float* kmean = (float*)(F.ws + WS_KMEAN); float* kmax = (float*)(F.ws + WS_KMAX);
    LAS float* red = (LAS float*)F.lds;
    LAS float* red2 = red + 32 * 128;
    for (int it = F.vcu; it < BATCH * NBLK * 4; it += F.G) {
        const int bn = it >> 2, cq = it & 3, cc = F.tid & 15, rg = F.tid >> 4;
        float s[8] = {0.f, 0.f, 0.f, 0.f, 0.f, 0.f, 0.f, 0.f}; float nmax = 0.f;
#pragma unroll
        for (int r = 0; r < 8; ++r) { const u32x4 v = *(const GAS u32x4*)(Kb + (size_t)(bn * 256 + rg * 8 + r) * 512 + cq * 128 + cc * 8);
            const float e0 = bf_lo(v.x), e1 = bf_hi(v.x), e2 = bf_lo(v.y), e3 = bf_hi(v.y), e4 = bf_lo(v.z), e5 = bf_hi(v.z), e6 = bf_lo(v.w), e7 = bf_hi(v.w);
            s[0] += e0; s[1] += e1; s[2] += e2; s[3] += e3; s[4] += e4; s[5] += e5; s[6] += e6; s[7] += e7;
            float q = (e0 * e0 + e1 * e1) + (e2 * e2 + e3 * e3) + (e4 * e4 + e5 * e5) + (e6 * e6 + e7 * e7);
            q += __shfl_xor(q, 1); q += __shfl_xor(q, 2); q += __shfl_xor(q, 4);
            nmax = fmaxf(nmax, q); }
#pragma unroll
        for (int j = 0; j < 8; ++j) red[rg * 128 + cc * 8 + j] = s[j];
        if ((cc & 7) == 0) red2[rg * 2 + (cc >> 3)] = nmax;
        __syncthreads();
        if (F.tid < 128) { float t = 0.f;
#pragma unroll
            for (int g = 0; g < 32; ++g) t += red[g * 128 + F.tid];
            kmean[(size_t)bn * 512 + cq * 128 + F.tid] = t * (1.f / 256.f); }
        if (F.tid < 2) { float m = 0.f;
#pragma unroll
            for (int g = 0; g < 32; ++g) m = fmaxf(m, red2[g * 2 + F.tid]);
            const int b = bn >> 5, n = bn & 31, h = cq * 2 + F.tid; kmax[(b * NH + h) * NBLK + n] = sqrtf(m); }
        __syncthreads();
    }
}

__device__ __forceinline__ void p4_topk(Frame& F) {
    const bf16_t* Q = (const bf16_t*)(F.ws + WS_Q); const float* kmean = (const float*)(F.ws + WS_KMEAN);
    unsigned* qcnt = F.ctl + CW_QCNT; unsigned* list = (unsigned*)(F.ws + WS_LIST);
    LAS float* km = (LAS float*)F.lds;
    LAS unsigned* lcnt = (LAS unsigned*)(F.lds + 16384);
    LAS unsigned* lbase = lcnt + 64;
    float* QN = (float*)(F.ws + WS_QN);
    for (int it = F.vcu; it < BATCH * NBLK * 4; it += F.G) {
        const int hp = it & 3, qb = (NBLK - 1) - (it >> 2) % NBLK, b = (it >> 2) / NBLK;
        for (int i = F.tid; i < 2 * qb * 16; i += NTHR) { const int hl = i / (qb * 16), r = i % (qb * 16), n = r >> 4, c4 = r & 15;
            *(LAS f32x4*)(km + (hl * 32 + n) * 64 + c4 * 4) = *(const GAS f32x4*)(kmean + (size_t)(b * NBLK + n) * 512 + (2 * hp + hl) * 64 + c4 * 4); }
        if (F.tid < 128) lcnt[F.tid] = 0u;
        __syncthreads();
        const int ql = F.tid & 255, hl = F.tid >> 8, h = 2 * hp + hl, t = qb * 256 + ql;
        float q[64];
        { const GAS u32x4* qp = (const GAS u32x4*)(Q + (size_t)(b * SEQ + t) * 512 + h * 64);
#pragma unroll
          for (int c = 0; c < 8; ++c) { const u32x4 v = qp[c]; q[8 * c] = bf_lo(v.x); q[8 * c + 1] = bf_hi(v.x); q[8 * c + 2] = bf_lo(v.y); q[8 * c + 3] = bf_hi(v.y); q[8 * c + 4] = bf_lo(v.z); q[8 * c + 5] = bf_hi(v.z); q[8 * c + 6] = bf_lo(v.w); q[8 * c + 7] = bf_hi(v.w); } }
        { float qq = 0.f;
#pragma unroll
          for (int c = 0; c < 64; ++c) qq += q[c] * q[c];
          QN[(size_t)(b * SEQ + t) * NH + h] = sqrtf(qq); }
        if (qb == 0) continue;
        float v0 = -3e38f, v1 = -3e38f, v2 = -3e38f; int i0 = 0, i1 = 0, i2 = 0;
#pragma unroll 2
        for (int n = 0; n < qb; ++n) {
            const LAS f32x4* kp = (const LAS f32x4*)(km + (hl * 32 + n) * 64); float g = 0.f;
#pragma unroll
            for (int c = 0; c < 16; ++c) { const f32x4 kv = kp[c]; g += q[4 * c] * kv.x + q[4 * c + 1] * kv.y + q[4 * c + 2] * kv.z + q[4 * c + 3] * kv.w; }
            if (g > v0) { v2 = v1; i2 = i1; v1 = v0; i1 = i0; v0 = g; i0 = n; }
            else if (g > v1) { v2 = v1; i2 = i1; v1 = g; i1 = n; }
            else if (g > v2) { v2 = g; i2 = n; }
        }
        const int nsel = qb < TOPK ? qb : TOPK;
        unsigned p0 = 0, p1 = 0, p2 = 0;
        p0 = __hip_atomic_fetch_add(&lcnt[hl * 32 + i0], 1u, __ATOMIC_RELAXED, __HIP_MEMORY_SCOPE_WORKGROUP);
        if (nsel > 1) p1 = __hip_atomic_fetch_add(&lcnt[hl * 32 + i1], 1u, __ATOMIC_RELAXED, __HIP_MEMORY_SCOPE_WORKGROUP);
        if (nsel > 2) p2 = __hip_atomic_fetch_add(&lcnt[hl * 32 + i2], 1u, __ATOMIC_RELAXED, __HIP_MEMORY_SCOPE_WORKGROUP);
        __syncthreads();
        if (F.tid < 64) { const int hl2 = F.tid >> 5, n = F.tid & 31; const unsigned c = lcnt[F.tid];
            lbase[F.tid] = c ? atomicAdd(&qcnt[(b * NH + 2 * hp + hl2) * NBLK + n], c) : 0u; }
        __syncthreads();
        const size_t lb = (size_t)((b * NH + h) * NBLK);
        list[(lb + i0) * CAPQ + lbase[hl * 32 + i0] + p0] = (unsigned)t | (0u << 13);
        if (nsel > 1) list[(lb + i1) * CAPQ + lbase[hl * 32 + i1] + p1] = (unsigned)t | (1u << 13);
        if (nsel > 2) list[(lb + i2) * CAPQ + lbase[hl * 32 + i2] + p2] = (unsigned)t | (2u << 13);
        __syncthreads();
    }
}

__device__ __forceinline__ int crow(int r, int hi) { return (r & 3) + 8 * (r >> 2) + 4 * hi; }
__device__ __forceinline__ float swap_max(float m) { auto rr = __builtin_amdgcn_permlane32_swap(__float_as_uint(m), __float_as_uint(m), false, false); return fmaxf(__uint_as_float(rr[0]), __uint_as_float(rr[1])); }
__device__ __forceinline__ float swap_sum(float m) { auto rr = __builtin_amdgcn_permlane32_swap(__float_as_uint(m), __float_as_uint(m), false, false); return __uint_as_float(rr[0]) + __uint_as_float(rr[1]); }
__device__ __forceinline__ s16x4 vtr(const LAS unsigned char* p) { return __builtin_bit_cast(s16x4, __builtin_amdgcn_ds_read_tr16_b64_v4i16((LAS s16x4*)p)); }
constexpr int AT_KV = 0, AT_OST = 131072, AT_LW = 147456, AT_META = 148480, AT_TAB = 149504, AT_PFX = 153728, AT_QCL = 155904, AT_KMX = 157952;
struct AttItem { int idx, j, own, nvalid; };
__device__ __forceinline__ AttItem att_decode(const LAS int* pfx, const LAS int* qcl, int it) {
    int lo = 0, hh = 511;
#pragma unroll 1
    while (lo < hh) { const int mid = (lo + hh + 1) >> 1; if (pfx[mid] <= it) lo = mid; else hh = mid - 1; }
    AttItem r; r.idx = lo; r.j = it - pfx[lo]; const int nch = pfx[lo + 1] - pfx[lo] - 1; r.own = (r.j == nch);
    const int rem = qcl[lo] - r.j * 256; r.nvalid = r.own ? 256 : (rem < 256 ? rem : 256); return r;
}
__device__ __forceinline__ void p5_attention(Frame& F, const Args& a) {
    const bf16_t* Q = (const bf16_t*)(F.ws + WS_Q); const bf16_t* Kb = (const bf16_t*)(F.ws + WS_K); const bf16_t* V = (const bf16_t*)(F.ws + WS_V);
    bf16_t* OP = (bf16_t*)(F.ws + WS_OPART); float* ML = (float*)(F.ws + WS_ML); const float* QN = (const float*)(F.ws + WS_QN);
    const unsigned* qcnt = F.ctl + CW_QCNT; const unsigned* list = (const unsigned*)(F.ws + WS_LIST);
    LAS unsigned char* lds = F.lds; const int tid = F.tid, lane = F.lane, w = F.wave, r32 = lane & 31, hi = lane >> 5;
    LAS float* tab = (LAS float*)(lds + AT_TAB); LAS int* pfx = (LAS int*)(lds + AT_PFX); LAS int* qcl = (LAS int*)(lds + AT_QCL); LAS float* kmx = (LAS float*)(lds + AT_KMX);
    for (int i = tid; i < NH * 129; i += NTHR) { const int h = i / 129, e = i % 129; float v = -INFINITY;
        if (e >= 1) { const int d = e - 1; int bk;
            if (d < 16) bk = d; else { bk = 16 + (d >= 19) + (d >= 21) + (d >= 24) + (d >= 27) + (d >= 31) + (d >= 35) + (d >= 40) + (d >= 46) + (d >= 52) + (d >= 59) + (d >= 67) + (d >= 77) + (d >= 87) + (d >= 99) + (d >= 113); }
            v = (a.rel_bias[bk * NH + h] - a.rel_bias[31 * NH + h]) * LOG2E; }
        tab[h * 132 + e] = v; }
    { const int c = (int)qcnt[tid]; qcl[tid] = c; pfx[tid + 1] = (c + 255) / 256 + 1; if (tid == 0) pfx[0] = 0; kmx[tid] = ((const float*)(F.ws + WS_KMAX))[tid]; }
    __syncthreads();
    if (tid < NH) { float mx = 0.f, mn = 0.f; for (int e = 1; e <= 128; ++e) { const float v = tab[tid * 132 + e]; mx = fmaxf(mx, v); mn = fminf(mn, v); }
        tab[tid * 132 + 129] = mx; tab[tid * 132 + 130] = a.rel_bias[31 * NH + tid] * LOG2E; tab[tid * 132 + 131] = mx - mn; }
    for (int o = 1; o < 512; o <<= 1) { int v = pfx[tid + 1]; if (tid >= o) v += pfx[tid + 1 - o]; __syncthreads(); pfx[tid + 1] = v; __syncthreads(); }
    const int nitems = pfx[512];
    LAS float* lw = (LAS float*)(lds + AT_LW) + w * 32; LAS unsigned* meta = (LAS unsigned*)(lds + AT_META) + w * 32;
    LAS bf16_t* stg = (LAS bf16_t*)(lds + AT_OST) + w * 1024;
    const int rowi = 32 * w + r32;
    const unsigned kv_lofs = (unsigned)((tid >> 3) * 1024 + (tid & 7) * 16);
    const unsigned k_lds = (unsigned)((tid >> 3) * 128 + (((tid & 7) ^ ((tid >> 4) & 7)) << 4));
    const unsigned v_lds = (unsigned)(32768 + (tid >> 3) * 128 + (((tid & 7) ^ (((tid >> 4) & 1) << 2)) << 4));
#define AT_K_LOAD(IDX) do { const int n_ = (IDX) & 31, h_ = ((IDX) >> 5) & 7, b_ = (IDX) >> 8; const char* gb_ = (const char*)(Kb + ((size_t)(b_ * SEQ + n_ * 256)) * 512 + h_ * 64); \
        _Pragma("unroll") for (int i_ = 0; i_ < 4; ++i_) kvreg[i_] = *(const GAS u32x4*)(gb_ + (size_t)i_ * 65536 + kv_lofs); } while (0)
#define AT_V_LOAD(IDX) do { const int n_ = (IDX) & 31, h_ = ((IDX) >> 5) & 7, b_ = (IDX) >> 8; const char* gb_ = (const char*)(V + ((size_t)(b_ * SEQ + n_ * 256)) * 512 + h_ * 64); \
        _Pragma("unroll") for (int i_ = 0; i_ < 4; ++i_) kvreg[i_] = *(const GAS u32x4*)(gb_ + (size_t)i_ * 65536 + kv_lofs); } while (0)
#define AT_K_WRITE(BUFO) do { _Pragma("unroll") for (int i_ = 0; i_ < 4; ++i_) *(LAS u32x4*)(lds + (BUFO) + k_lds + i_ * 8192) = kvreg[i_]; } while (0)
#define AT_V_WRITE(BUFO) do { _Pragma("unroll") for (int i_ = 0; i_ < 4; ++i_) *(LAS u32x4*)(lds + (BUFO) + v_lds + i_ * 8192) = kvreg[i_]; } while (0)
#define AT_ENT(IT, OUT) do { const int n_ = (IT).idx & 31; const bool v_ = rowi < (IT).nvalid; \
        OUT = (IT).own ? ((unsigned)(n_ * 256 + rowi) | (3u << 13)) : list[(size_t)(IT).idx * CAPQ + (IT).j * 256 + (v_ ? rowi : 0)]; } while (0)
#define AT_Q_LOAD(IT, ENT, QF, QNV) do { const int h_ = ((IT).idx >> 5) & 7, b_ = (IT).idx >> 8; const int t_ = (int)((ENT) & 8191u); \
        const GAS bf16x8* qp_ = (const GAS bf16x8*)(Q + (size_t)(b_ * SEQ + t_) * 512 + h_ * 64 + 8 * hi); \
        _Pragma("unroll") for (int s_ = 0; s_ < 4; ++s_) QF[s_] = qp_[2 * s_]; QNV = QN[(size_t)(b_ * SEQ + t_) * NH + h_]; } while (0)
    int it = F.vcu; int buf = 0;
    AttItem cur; cur.idx = 0; cur.j = 0; cur.own = 1; cur.nvalid = 0;
    u32x4 kvreg[4]; bf16x8 qf[4]; float qn = 0.f; unsigned ent = 0u;
    if (it < nitems) { cur = att_decode(pfx, qcl, it); AT_K_LOAD(cur.idx); AT_ENT(cur, ent); AT_K_WRITE(AT_KV); AT_V_LOAD(cur.idx); AT_Q_LOAD(cur, ent, qf, qn); AT_V_WRITE(AT_KV); }
    for (; it < nitems; it += F.G, buf ^= 1) {
        const int idx = cur.idx; const bool own = cur.own != 0; const int nvalid = cur.nvalid;
        const int n = idx & 31, h = (idx >> 5) & 7, b = idx >> 8;
        const bool valid = rowi < nvalid;
        const int tq = (int)(ent & 8191u), slot = (int)(ent >> 13) & 3;
        if (hi == 0) meta[r32] = (unsigned)tq | ((unsigned)slot << 13) | (valid ? 0x8000u : 0u);
        const bool has_next = it + F.G < nitems;
        AttItem nxt = cur; unsigned ent_n = ent;
        if (has_next) { nxt = att_decode(pfx, qcl, it + F.G); AT_ENT(nxt, ent_n); }
        asm volatile("s_waitcnt lgkmcnt(0)" ::: "memory"); __builtin_amdgcn_s_barrier(); asm volatile("" ::: "memory");
        if (has_next) AT_K_LOAD(nxt.idx);
        const LAS unsigned char* kt = lds + AT_KV + buf * 65536; const LAS unsigned char* vt = kt + 32768;
        const bool active = 32 * w < nvalid;
        const int imax = own ? w : 7;
        const int kbase = n * 256; const LAS float* tb = tab + h * 132; const int dq = tq - kbase - 4 * hi + 1;
        f32x16 p[8]; float mref = 0.f, ls = 0.f;
        if (active) {
            const float kq = qn * kmx[idx];
            mref = kq + tb[129];
            if (__any(valid && (2.f * kq + tb[131] > 100.f))) {
                float mx = -INFINITY;
#pragma unroll
                for (int i = 0; i < 8; ++i) if (i <= imax) { const int row = 32 * i + r32; const LAS unsigned char* kr = kt + row * 128; const int sw = (row >> 1) & 7;
                    f32x16 accp = {0.f, 0.f, 0.f, 0.f, 0.f, 0.f, 0.f, 0.f, 0.f, 0.f, 0.f, 0.f, 0.f, 0.f, 0.f, 0.f};
#pragma unroll
                    for (int s = 0; s < 4; ++s) { const bf16x8 kf = *(const LAS bf16x8*)(kr + (((2 * s + hi) ^ sw) << 4)); accp = __builtin_amdgcn_mfma_f32_32x32x16_bf16(kf, qf[s], accp, 0, 0, 0); }
#pragma unroll
                    for (int r = 0; r < 16; ++r) { int di = dq - 32 * i - ((r & 3) + 8 * (r >> 2)); di = di < 0 ? 0 : (di > 128 ? 128 : di); mx = fmaxf(mx, accp[r] + tb[di]); } }
                mref = swap_max(mx);
            }
            { const float ni = -mref; const f32x16 init = {ni, ni, ni, ni, ni, ni, ni, ni, ni, ni, ni, ni, ni, ni, ni, ni};
#pragma unroll
              for (int i = 0; i < 8; ++i) if (i <= imax) { const int row = 32 * i + r32; const LAS unsigned char* kr = kt + row * 128; const int sw = (row >> 1) & 7;
                  f32x16 accp = init;
#pragma unroll
                  for (int s = 0; s < 4; ++s) { const bf16x8 kf = *(const LAS bf16x8*)(kr + (((2 * s + hi) ^ sw) << 4)); accp = __builtin_amdgcn_mfma_f32_32x32x16_bf16(kf, qf[s], accp, 0, 0, 0); }
                  p[i] = accp; } }
        }
        if (has_next) { AT_K_WRITE(AT_KV + (buf ^ 1) * 65536); AT_V_LOAD(nxt.idx); }
        if (active) {
#pragma unroll
            for (int i = 0; i < 8; ++i) if (i <= imax) {
                if (__any(valid && (tq - kbase - 32 * i - 31 < 127))) {
#pragma unroll
                    for (int r = 0; r < 16; ++r) { int di = dq - 32 * i - ((r & 3) + 8 * (r >> 2)); di = di < 0 ? 0 : (di > 128 ? 128 : di); p[i][r] += tb[di]; } } }
#pragma unroll
            for (int i = 0; i < 8; ++i) if (i <= imax) {
#pragma unroll
                for (int r = 0; r < 16; ++r) { const float e = __builtin_amdgcn_exp2f(p[i][r]); p[i][r] = e; ls += e; } }
            ls = swap_sum(ls);
        }
        if (has_next) AT_V_WRITE(AT_KV + (buf ^ 1) * 65536);
        if (active) {
            f32x16 o0 = {0.f, 0.f, 0.f, 0.f, 0.f, 0.f, 0.f, 0.f, 0.f, 0.f, 0.f, 0.f, 0.f, 0.f, 0.f, 0.f}, o1 = o0;
            { const int L = lane & 15, qq = L >> 2, pp = L & 3, sq = (qq >> 1) & 1, cc = 2 * ((lane >> 4) & 1) + (pp >> 1);
              const LAS unsigned char* vb0 = vt + (4 * hi + qq) * 128 + ((4 * sq + cc) << 4) + (pp & 1) * 8;
              const LAS unsigned char* vb1 = vt + (4 * hi + qq) * 128 + ((4 * (1 ^ sq) + cc) << 4) + (pp & 1) * 8;
#pragma unroll
              for (int i = 0; i < 8; ++i) if (i <= imax) {
#pragma unroll
                  for (int s2 = 0; s2 < 2; ++s2) {
                      u32x4 pw; pw.x = cvt_pk_bf16(p[i][8 * s2 + 0], p[i][8 * s2 + 1]); pw.y = cvt_pk_bf16(p[i][8 * s2 + 2], p[i][8 * s2 + 3]); pw.z = cvt_pk_bf16(p[i][8 * s2 + 4], p[i][8 * s2 + 5]); pw.w = cvt_pk_bf16(p[i][8 * s2 + 6], p[i][8 * s2 + 7]);
                      const bf16x8 pa = __builtin_bit_cast(bf16x8, pw); const int off = (32 * i + 16 * s2) * 128;
                      const s16x4 a0 = vtr(vb0 + off), a1 = vtr(vb0 + off + 1024), c0 = vtr(vb1 + off), c1 = vtr(vb1 + off + 1024);
                      const bf16x8 vf0 = {a0[0], a0[1], a0[2], a0[3], a1[0], a1[1], a1[2], a1[3]}, vf1 = {c0[0], c0[1], c0[2], c0[3], c1[0], c1[1], c1[2], c1[3]};
                      o0 = __builtin_amdgcn_mfma_f32_32x32x16_bf16(pa, vf0, o0, 0, 0, 0); o1 = __builtin_amdgcn_mfma_f32_32x32x16_bf16(pa, vf1, o1, 0, 0, 0); } } }
            if (has_next) AT_Q_LOAD(nxt, ent_n, qf, qn);
            if (hi == 0) { lw[r32] = ls; if (valid) ML[((size_t)(b * SEQ + tq) * NH + h) * 4 + slot] = mref + __builtin_amdgcn_logf(ls) + tb[130]; }
            LDS_WAIT();
            float rl[16];
#pragma unroll
            for (int r = 0; r < 16; ++r) rl[r] = __builtin_amdgcn_rcpf(lw[crow(r, hi)]);
#pragma unroll
            for (int d0 = 0; d0 < 2; ++d0) {
#pragma unroll
                for (int r = 0; r < 16; ++r) stg[crow(r, hi) * 32 + r32] = (bf16_t)(cvt_pk_bf16((d0 ? o1[r] : o0[r]) * rl[r], 0.f) & 0xffffu);
                LDS_WAIT();
#pragma unroll
                for (int i = 0; i < 2; ++i) { const int id = lane + 64 * i, row = id >> 2, ch = id & 3; const unsigned mt = meta[row];
                    if (mt & 0x8000u) { const u32x4 v = *(const LAS u32x4*)(stg + row * 32 + ch * 8); const int tt = (int)(mt & 8191u), sl = (int)(mt >> 13) & 3;
                        *(GAS u32x4*)(OP + (((size_t)(b * SEQ + tt) * NH + h) * 4 + sl) * 64 + d0 * 32 + ch * 8) = v; } }
                LDS_WAIT();
            }
        }
        if (!active && has_next) AT_Q_LOAD(nxt, ent_n, qf, qn);
        cur = nxt; ent = ent_n;
    }
#undef AT_K_LOAD
#undef AT_V_LOAD
#undef AT_K_WRITE
#undef AT_V_WRITE
#undef AT_ENT
#undef AT_Q_LOAD
    __syncthreads();
}

__device__ __forceinline__ void p6_combine_conv(Frame& F, const Args& a) {
    const bf16_t* OP = (const bf16_t*)(F.ws + WS_OPART); const float* ML = (const float*)(F.ws + WS_ML);
    const bf16_t* U = (const bf16_t*)(F.ws + WS_U); const bf16_t* BG = (const bf16_t*)(F.ws + WS_BG);
    bf16_t* ATT = (bf16_t*)(F.ws + WS_R1); bf16_t* CV = ATT + 512;
    const int gw = F.vcu * NWAVES + F.wave, NGW = F.G * NWAVES, lane = F.lane;
    float cw[3][8];
#pragma unroll
    for (int j = 0; j < 3; ++j)
#pragma unroll
        for (int c = 0; c < 8; ++c) cw[j][c] = a.conv_w[j * CWD + lane * 8 + c];
    const int hd = lane >> 3, ch = lane & 7;
    for (int t0 = gw; t0 < T; t0 += 2 * NGW) {
        int tg[2]; tg[0] = t0; tg[1] = (t0 + NGW < T) ? t0 + NGW : t0;
        f32x4 l4[2]; u32x4 ov[2][4], uv[2][3], gv[2];
#pragma unroll
        for (int q = 0; q < 2; ++q) { const int tb = tg[q] & (SEQ - 1), qb = tb >> 8, nsel = qb < TOPK ? qb : TOPK; const size_t pb = ((size_t)tg[q] * NH + hd) * 4;
            l4[q] = *(const GAS f32x4*)(ML + pb);
#pragma unroll
            for (int sl = 0; sl < 4; ++sl) ov[q][sl] = (sl == 3 || sl < nsel) ? *(const GAS u32x4*)(OP + (pb + sl) * 64 + ch * 8) : (u32x4){0u, 0u, 0u, 0u};
            uv[q][2] = *(const GAS u32x4*)(U + (size_t)tg[q] * 512 + lane * 8);
            uv[q][1] = tb >= 1 ? *(const GAS u32x4*)(U + (size_t)(tg[q] - 1) * 512 + lane * 8) : (u32x4){0u, 0u, 0u, 0u};
            uv[q][0] = tb >= 2 ? *(const GAS u32x4*)(U + (size_t)(tg[q] - 2) * 512 + lane * 8) : (u32x4){0u, 0u, 0u, 0u};
            gv[q] = *(const GAS u32x4*)(BG + (size_t)tg[q] * 512 + lane * 8); }
#pragma unroll
        for (int q = 0; q < 2; ++q) if (q == 0 || tg[1] != tg[0]) { const int tb = tg[q] & (SEQ - 1), qb = tb >> 8, nsel = qb < TOPK ? qb : TOPK;
            const float ls[4] = {l4[q].x, l4[q].y, l4[q].z, l4[q].w}; float M = ls[3];
#pragma unroll
            for (int sl = 0; sl < 3; ++sl) if (sl < nsel) M = fmaxf(M, ls[sl]);
            float acc[8] = {0.f, 0.f, 0.f, 0.f, 0.f, 0.f, 0.f, 0.f}; float W = 0.f;
#pragma unroll
            for (int sl = 0; sl < 4; ++sl) if (sl == 3 || sl < nsel) { const float wg = __builtin_amdgcn_exp2f(ls[sl] - M); W += wg; const u32x4 v = ov[q][sl];
                acc[0] += wg * bf_lo(v.x); acc[1] += wg * bf_hi(v.x); acc[2] += wg * bf_lo(v.y); acc[3] += wg * bf_hi(v.y); acc[4] += wg * bf_lo(v.z); acc[5] += wg * bf_hi(v.z); acc[6] += wg * bf_lo(v.w); acc[7] += wg * bf_hi(v.w); }
            const float rW = 1.f / W;
            { u32x4 o; o.x = cvt_pk_bf16(acc[0] * rW, acc[1] * rW); o.y = cvt_pk_bf16(acc[2] * rW, acc[3] * rW); o.z = cvt_pk_bf16(acc[4] * rW, acc[5] * rW); o.w = cvt_pk_bf16(acc[6] * rW, acc[7] * rW);
              *(GAS u32x4*)(ATT + (size_t)tg[q] * 1024 + lane * 8) = o; }
            float y[8] = {0.f, 0.f, 0.f, 0.f, 0.f, 0.f, 0.f, 0.f};
#pragma unroll
            for (int j = 0; j < 3; ++j) { const u32x4 v = uv[q][j];
                y[0] += cw[j][0] * bf_lo(v.x); y[1] += cw[j][1] * bf_hi(v.x); y[2] += cw[j][2] * bf_lo(v.y); y[3] += cw[j][3] * bf_hi(v.y); y[4] += cw[j][4] * bf_lo(v.z); y[5] += cw[j][5] * bf_hi(v.z); y[6] += cw[j][6] * bf_lo(v.w); y[7] += cw[j][7] * bf_hi(v.w); }
            { const u32x4 g = gv[q];
              u32x4 o; o.x = cvt_pk_bf16(y[0] * bf_lo(g.x), y[1] * bf_hi(g.x)); o.y = cvt_pk_bf16(y[2] * bf_lo(g.y), y[3] * bf_hi(g.y)); o.z = cvt_pk_bf16(y[4] * bf_lo(g.z), y[5] * bf_hi(g.z)); o.w = cvt_pk_bf16(y[6] * bf_lo(g.w), y[7] * bf_hi(g.w));
              *(GAS u32x4*)(CV + (size_t)tg[q] * 1024 + lane * 8) = o; } }
    }
}

struct EpiGateFused {
    static constexpr bool PERM = true;
    bf16_t* MG; const bf16_t* SA; const bf16_t* SC;
    __device__ __forceinline__ void mid(f32x4 (&acc)[2][2][4][2], const pg8::Unit& u, int wr, int wc, int fr, int fq) const {
        const __amdgpu_buffer_rsrc_t ra = __builtin_amdgcn_make_buffer_rsrc((void*)SA, 0, T * D * 2, 0x00020000), rc = __builtin_amdgcn_make_buffer_rsrc((void*)SC, 0, T * D * 2, 0x00020000);
        const int voff = ((u.pm * 256 + wr * 64 + fr) * 1024 + u.pn * 256 + wc * 32 + 8 * fq) * 2;
#pragma unroll
        for (int ai = 0; ai < 2; ++ai) {
            u32x4 ga[4][2], gc[4][2];
#pragma unroll
            for (int m = 0; m < 4; ++m)
#pragma unroll
                for (int bj = 0; bj < 2; ++bj) { const int so = ((ai * 128 + m * 16) * 1024 + bj * 128) * 2; ga[m][bj] = __builtin_amdgcn_raw_buffer_load_b128(ra, voff, so, 0); gc[m][bj] = __builtin_amdgcn_raw_buffer_load_b128(rc, voff, so, 0); }
#pragma unroll
            for (int m = 0; m < 4; ++m)
#pragma unroll
                for (int bj = 0; bj < 2; ++bj) { const u32x4 a_ = ga[m][bj], c_ = gc[m][bj]; f32x4 r0, r1;
                    r0[0] = bf_lo(a_.x) * __builtin_amdgcn_rcpf(fmaxf(bf_lo(c_.x), 1e-30f)); r0[1] = bf_hi(a_.x) * __builtin_amdgcn_rcpf(fmaxf(bf_hi(c_.x), 1e-30f));
                    r0[2] = bf_lo(a_.y) * __builtin_amdgcn_rcpf(fmaxf(bf_lo(c_.y), 1e-30f)); r0[3] = bf_hi(a_.y) * __builtin_amdgcn_rcpf(fmaxf(bf_hi(c_.y), 1e-30f));
                    r1[0] = bf_lo(a_.z) * __builtin_amdgcn_rcpf(fmaxf(bf_lo(c_.z), 1e-30f)); r1[1] = bf_hi(a_.z) * __builtin_amdgcn_rcpf(fmaxf(bf_hi(c_.z), 1e-30f));
                    r1[2] = bf_lo(a_.w) * __builtin_amdgcn_rcpf(fmaxf(bf_lo(c_.w), 1e-30f)); r1[3] = bf_hi(a_.w) * __builtin_amdgcn_rcpf(fmaxf(bf_hi(c_.w), 1e-30f));
                    acc[ai][bj][m][0] *= r0; acc[ai][bj][m][1] *= r1; }
            asm volatile("" ::: "memory");
        }
    }
    __device__ __forceinline__ void operator()(const f32x4 (&acc)[2][2][4][2], const pg8::Unit& u, int wr, int wc, int fr, int fq) const {
        const __amdgpu_buffer_rsrc_t rc = __builtin_amdgcn_make_buffer_rsrc((void*)SC, 0, T * D * 2, 0x00020000), rm = __builtin_amdgcn_make_buffer_rsrc((void*)MG, 0, T * D * 2, 0x00020000);
        const int voff = ((u.pm * 256 + wr * 64 + fr) * 1024 + u.pn * 256 + wc * 32 + 8 * fq) * 2;
#pragma unroll
        for (int ai = 0; ai < 2; ++ai)
#pragma unroll
            for (int m = 0; m < 4; ++m)
#pragma unroll
                for (int bj = 0; bj < 2; ++bj) { const int so = ((ai * 128 + m * 16) * 1024 + bj * 128) * 2;
                    const u32x4 g = __builtin_amdgcn_raw_buffer_load_b128(rc, voff, so, 0); const f32x4 a0 = acc[ai][bj][m][0], a1 = acc[ai][bj][m][1];
                    u32x4 w; w.x = cvt_pk_bf16(a0[0] * bf_lo(g.x), a0[1] * bf_hi(g.x)); w.y = cvt_pk_bf16(a0[2] * bf_lo(g.y), a0[3] * bf_hi(g.y));
                    w.z = cvt_pk_bf16(a1[0] * bf_lo(g.z), a1[1] * bf_hi(g.z)); w.w = cvt_pk_bf16(a1[2] * bf_lo(g.w), a1[3] * bf_hi(g.w));
                    __builtin_amdgcn_raw_buffer_store_b128(w, rm, voff, so, 0); }
    }
};
struct EpiDelta {
    static constexpr bool PERM = true;
    bf16_t* DL; const float* g1;
    __device__ __forceinline__ void operator()(const f32x4 (&acc)[2][2][4][2], const pg8::Unit& u, int wr, int wc, int fr, int fq) const {
        const int row0 = u.pm * 256 + wr * 64 + fr, col0 = u.pn * 256 + wc * 32 + 8 * fq; const int b = (u.pm * 256) / SEQ;
        f32x4 gv[2][2];
#pragma unroll
        for (int bj = 0; bj < 2; ++bj)
#pragma unroll
            for (int n = 0; n < 2; ++n) gv[bj][n] = *(const GAS f32x4*)(g1 + (size_t)b * D + col0 + bj * 128 + n * 4);
#pragma unroll
        for (int ai = 0; ai < 2; ++ai)
#pragma unroll
            for (int m = 0; m < 4; ++m)
#pragma unroll
                for (int bj = 0; bj < 2; ++bj) { const f32x4 v0 = acc[ai][bj][m][0] * gv[bj][0], v1 = acc[ai][bj][m][1] * gv[bj][1];
                    u32x4 w; w.x = cvt_pk_bf16(v0[0], v0[1]); w.y = cvt_pk_bf16(v0[2], v0[3]); w.z = cvt_pk_bf16(v1[0], v1[1]); w.w = cvt_pk_bf16(v1[2], v1[3]);
                    *(GAS u32x4*)(DL + (size_t)(row0 + ai * 128 + m * 16) * 1024 + col0 + bj * 128) = w; }
    }
};

__device__ __forceinline__ void p9_norm_route(Frame& F, const Args& a) {
    const int gw = F.vcu * NWAVES + F.wave, NGW = F.G * NWAVES, lane = F.lane, tid = F.tid;
#ifndef PROBE_PH
#define PROBE_PH (-1)
#endif
    for (int rep_ = 0; rep_ < ((PROBE_PH) == 90 ? 2 : 1); ++rep_)
    {
        LAS float* scr = (LAS float*)(F.lds + F.wave * 8704);
        constexpr int I_G = (D / 64) * (DE / 32), I_D = (DE / 64) * (D / 32), PER_E = 2 * I_G + I_D;
        for (int it = gw; it < NE * PER_E; it += NGW) {
            const int e = it / PER_E; int r = it % PER_E;
            bf16_t* wgu = (bf16_t*)(F.ws + WS_WGU) + (size_t)e * 1024 * 1024; bf16_t* wd = (bf16_t*)(F.ws + WS_WD) + (size_t)e * 1024 * 512;
            if (r < 2 * I_G) { const int up = r >= I_G; if (up) r -= I_G; const int nb = r % (DE / 32), kb = r / (DE / 32), n0 = 32 * nb;
                transpose_item((up ? a.w_eu : a.w_eg) + (size_t)e * D * DE, D, DE, wgu, 64 * kb, n0, 256 * (n0 >> 7) + (n0 & 127) + (up ? 128 : 0), scr, lane); }
            else { r -= 2 * I_G; const int nb = r % (D / 32), kb = r / (D / 32); transpose_item(a.w_ed + (size_t)e * DE * D, DE, D, wd, 64 * kb, 32 * nb, 32 * nb, scr, lane); }
        }
    }
    __syncthreads();
    LAS unsigned char* wrl = F.lds;
    LAS float* mul = (LAS float*)(F.lds + 99328); LAS float* add = mul + 2 * D;
    LAS float* ssq = (LAS float*)(F.lds + 115712);
    LAS float* lgx = (LAS float*)(F.lds + 116224);
    LAS float* rb = (LAS float*)(F.lds + 140800);
    LAS int* asg_e = (LAS int*)(F.lds + 141056);
    LAS unsigned* asg_p = (LAS unsigned*)(asg_e + 128);
    LAS float* asg_w = (LAS float*)(asg_p + 128);
    LAS unsigned* lcnt = (LAS unsigned*)(asg_w + 128);
    LAS unsigned* lbase = lcnt + 32;
    { const bf16_t* wrt = (const bf16_t*)(F.ws + WS_WRT); const float* modv = (const float*)(F.ws + WS_MODV);
#pragma unroll
      for (int i = 0; i < 12; ++i) { const int id = tid + NTHR * i, c = id >> 7, kc = id & 127; *(LAS u32x4*)(wrl + (c * 1032 + kc * 8) * 2) = *(const GAS u32x4*)(wrt + (size_t)c * D + kc * 8); }
      *(LAS f32x4*)(mul + 4 * tid) = *(const GAS f32x4*)(modv + 6 * D + 4 * tid); *(LAS f32x4*)(add + 4 * tid) = *(const GAS f32x4*)(modv + 8 * D + 4 * tid);
      if (tid < 48) rb[tid] = tid < NGRP ? a.b_rg[tid] : tid < NGRP + NE ? a.b_re[tid - NGRP] : 0.f; }
    __syncthreads();
    const bf16_t* DL = (const bf16_t*)(F.ws + WS_R1); bf16_t* H2 = (bf16_t*)a.out;
    int* tok_e = (int*)(F.ws + WS_TOKE); int* tok_p = (int*)(F.ws + WS_TOKP); int* rowidx = (int*)(F.ws + WS_ROWIDX); float* roww = (float*)(F.ws + WS_ROWW);
    unsigned* ecnt = F.ctl + CW_ECNT;
    const int wv = F.wave, tile = wv & 3, half = wv >> 2, r = lane & 15, kq = lane >> 4;
    for (int rbk = F.vcu; rbk < T / 64; rbk += F.G) {
        if (tid < 32) lcnt[tid] = 0u;
        const int m0 = rbk * 64 + tile * 16, b = m0 / SEQ, kb = half * 512 + 8 * kq;
        const float* xr = a.x + (size_t)(m0 + r) * D + kb; const bf16_t* dr = DL + (size_t)(m0 + r) * D + kb;
        float ss = 0.f;
#pragma unroll
        for (int hb = 0; hb < 2; ++hb) { f32x4 xa[8], xb[8]; u32x4 dl[8];
#pragma unroll
            for (int sx = 0; sx < 8; ++sx) { xa[sx] = *(const GAS f32x4*)(xr + 32 * (8 * hb + sx)); xb[sx] = *(const GAS f32x4*)(xr + 32 * (8 * hb + sx) + 4); dl[sx] = *(const GAS u32x4*)(dr + 32 * (8 * hb + sx)); }
#pragma unroll
            for (int sx = 0; sx < 8; ++sx) { const u32x4 d = dl[sx]; const f32x4 u0 = xa[sx] + (f32x4){bf_lo(d.x), bf_hi(d.x), bf_lo(d.y), bf_hi(d.y)}, u1 = xb[sx] + (f32x4){bf_lo(d.z), bf_hi(d.z), bf_lo(d.w), bf_hi(d.w)};
                ss += (u0.x * u0.x + u0.y * u0.y) + (u0.z * u0.z + u0.w * u0.w) + (u1.x * u1.x + u1.y * u1.y) + (u1.z * u1.z + u1.w * u1.w); }
            asm volatile("" ::: "memory"); }
        ss += __shfl_xor(ss, 16); ss += __shfl_xor(ss, 32);
        if (kq == 0) ssq[wv * 16 + r] = ss;
        __syncthreads();
        const float rstd = 1.f / sqrtf((ssq[wv * 16 + r] + ssq[(wv ^ 4) * 16 + r]) * (1.f / D) + NORM_EPS);
        f32x4 acc[3] = {{0.f, 0.f, 0.f, 0.f}, {0.f, 0.f, 0.f, 0.f}, {0.f, 0.f, 0.f, 0.f}};
        bf16_t* hrow = H2 + (size_t)(m0 + r) * D + kb;
#pragma unroll
        for (int hb = 0; hb < 2; ++hb) { f32x4 xa[8], xb[8]; u32x4 dl[8];
#pragma unroll
            for (int sx = 0; sx < 8; ++sx) { xa[sx] = *(const GAS f32x4*)(xr + 32 * (8 * hb + sx)); xb[sx] = *(const GAS f32x4*)(xr + 32 * (8 * hb + sx) + 4); dl[sx] = *(const GAS u32x4*)(dr + 32 * (8 * hb + sx)); }
#pragma unroll
            for (int sx = 0; sx < 8; ++sx) { const int kk = kb + 32 * (8 * hb + sx); const u32x4 d = dl[sx];
                const f32x4 u0 = xa[sx] + (f32x4){bf_lo(d.x), bf_hi(d.x), bf_lo(d.y), bf_hi(d.y)}, u1 = xb[sx] + (f32x4){bf_lo(d.z), bf_hi(d.z), bf_lo(d.w), bf_hi(d.w)};
                const f32x4 ml = *(const LAS f32x4*)(mul + b * D + kk), mh = *(const LAS f32x4*)(mul + b * D + kk + 4), al = *(const LAS f32x4*)(add + b * D + kk), ah = *(const LAS f32x4*)(add + b * D + kk + 4);
                const f32x4 hl = u0 * rstd * ml + al, hh = u1 * rstd * mh + ah;
                u32x4 hw; hw.x = cvt_pk_bf16(hl.x, hl.y); hw.y = cvt_pk_bf16(hl.z, hl.w); hw.z = cvt_pk_bf16(hh.x, hh.y); hw.w = cvt_pk_bf16(hh.z, hh.w);
                *(GAS u32x4*)(hrow + 32 * (8 * hb + sx)) = hw;
                const bf16x8 hf = __builtin_bit_cast(bf16x8, hw);
#pragma unroll
                for (int nt = 0; nt < 3; ++nt) { const bf16x8 wf = *(const LAS bf16x8*)(wrl + ((16 * nt + r) * 1032 + kk) * 2); acc[nt] = __builtin_amdgcn_mfma_f32_16x16x32_bf16(hf, wf, acc[nt], 0, 0, 0); } }
            asm volatile("" ::: "memory"); }
#pragma unroll
        for (int nt = 0; nt < 3; ++nt)
#pragma unroll
            for (int j = 0; j < 4; ++j) lgx[(wv * 16 + 4 * kq + j) * 48 + 16 * nt + r] = acc[nt][j];
        __syncthreads();
        if (tid < 64) {
            const int tl = tid >> 4, rw = tid & 15; float lg[36];
#pragma unroll
            for (int c4 = 0; c4 < 9; ++c4) { const f32x4 p = *(const LAS f32x4*)(lgx + (tl * 16 + rw) * 48 + 4 * c4), q = *(const LAS f32x4*)(lgx + ((tl + 4) * 16 + rw) * 48 + 4 * c4), bz = *(const LAS f32x4*)(rb + 4 * c4);
                lg[4 * c4] = p.x + q.x + bz.x; lg[4 * c4 + 1] = p.y + q.y + bz.y; lg[4 * c4 + 2] = p.z + q.z + bz.z; lg[4 * c4 + 3] = p.w + q.w + bz.w; }
            int gs = 0; float gm = lg[0];
#pragma unroll
            for (int g = 1; g < 4; ++g) if (lg[g] > gm) { gm = lg[g]; gs = g; }
            float gden = 0.f;
#pragma unroll
            for (int g = 0; g < 4; ++g) gden += __expf(lg[g] - gm);
            const float g_w = 1.f / gden;
            float el[8];
#pragma unroll
            for (int j = 0; j < 8; ++j) el[j] = gs == 0 ? lg[4 + j] : gs == 1 ? lg[12 + j] : gs == 2 ? lg[20 + j] : lg[28 + j];
            int i0 = 0; float m0v = el[0];
#pragma unroll
            for (int j = 1; j < 8; ++j) if (el[j] > m0v) { m0v = el[j]; i0 = j; }
            int i1 = -1; float m1v = -3e38f;
#pragma unroll
            for (int j = 0; j < 8; ++j) if (j != i0 && el[j] > m1v) { m1v = el[j]; i1 = j; }
            const float e1 = __expf(m1v - m0v), w0 = g_w / (1.f + e1), w1 = g_w * e1 / (1.f + e1);
            asg_e[tid * 2] = gs * 8 + i0; asg_e[tid * 2 + 1] = gs * 8 + i1; asg_w[tid * 2] = w0; asg_w[tid * 2 + 1] = w1;
        }
        __syncthreads();
        if (tid < 128) asg_p[tid] = __hip_atomic_fetch_add(&lcnt[asg_e[tid]], 1u, __ATOMIC_RELAXED, __HIP_MEMORY_SCOPE_WORKGROUP);
        __syncthreads();
        if (tid < 32) { const unsigned c = lcnt[tid]; lbase[tid] = c ? atomicAdd(&ecnt[tid], c) : 0u; }
        __syncthreads();
        if (tid < 128) { const int m = rbk * 64 + (tid >> 1), e = asg_e[tid]; const int pos = (int)(lbase[e] + asg_p[tid]);
            tok_e[m * 2 + (tid & 1)] = e; tok_p[m * 2 + (tid & 1)] = pos; rowidx[(size_t)e * ECAP + pos] = m; roww[(size_t)e * ECAP + pos] = asg_w[tid]; }
        __syncthreads();
    }
}

struct MoeOrder {
    const LAS int* tpre;
    const LAS int* cnts;
    const LAS int* tlist;
    const LAS int* rowtab;
    const char* A; const char* B; size_t a_tile_bytes, b_exp_bytes, b_tile_bytes; int G, c, nunits, nfull_units;
    __device__ bool next(int i, pg8::Unit& u) const {
        const long L = (long)i * G + c; if (L >= nunits) return false;
        int wgid = (int)L;
        if (wgid < nfull_units) { const int q = nfull_units / 8, r = nfull_units % 8, xcd = wgid % 8, off = wgid / 8; wgid = (xcd < r ? xcd * (q + 1) : r * (q + 1) + (xcd - r) * q) + off; }
        const int ti = tlist[wgid >> 2]; u.pn = wgid & 3; u.pm = ti;
        int e = 0;
#pragma unroll 1
        for (int s = 16; s >= 1; s >>= 1) if (tpre[e + s] <= ti) e += s;
        u.e = e; const int r0 = (ti - tpre[e]) * 256; u.nvalid = cnts[e] - r0 < 256 ? cnts[e] - r0 : 256;
        u.A = A + (size_t)ti * a_tile_bytes; u.B = B + (size_t)e * b_exp_bytes + (size_t)u.pn * b_tile_bytes; return true;
    }
    __device__ __forceinline__ unsigned arow(int i, int r) const { return (unsigned)rowtab[(i & 7) * 256 + r]; }
};
__device__ __forceinline__ int moe_setup(Frame& F, LAS int* tpre, LAS int* cnts, LAS int* tlist, int& nfull) {
    const unsigned* ecnt = F.ctl + CW_ECNT;
    if (F.tid < 64) {
        const int e = F.tid & 31; const int c = (int)ecnt[e]; const int nt = (c + 255) >> 8, nvl = c - 256 * (nt - 1);
        const int nf = nt > 0 ? (nt - 1) + (nvl > 128 ? 1 : 0) : 0;
        int pt = nt, pf = nf;
#pragma unroll
        for (int o = 1; o < 32; o <<= 1) { const int a = __shfl_up(pt, o, 32), b2 = __shfl_up(pf, o, 32); if (e >= o) { pt += a; pf += b2; } }
        const int tot = __shfl(pt, 31, 32), totf = __shfl(pf, 31, 32);
        if (F.tid < 32) { tpre[e] = pt - nt; cnts[e] = c; if (e == 31) { tpre[32] = tot; tpre[33] = totf; }
            if (tlist) { const int t0 = pt - nt, f0 = pf - nf, l0 = (pt - nt) - (pf - nf);
                for (int t = 0; t < nt; ++t) { const bool light = (t == nt - 1) && !(nvl > 128); if (light) tlist[totf + l0] = t0 + t; else tlist[f0 + t] = t0 + t; } } }
    }
    __syncthreads();
    nfull = tpre[33];
    return tpre[32];
}
struct EpiSwiglu {
    static constexpr bool PERM = true;
    bf16_t* ACT;
    __device__ __forceinline__ void operator()(const f32x4 (&acc)[2][2][4][2], const pg8::Unit& u, int wr, int wc, int fr, int fq) const {
        const int row0 = u.pm * 256 + wr * 64 + fr, ch0 = u.pn * 128 + wc * 32 + 8 * fq;
#pragma unroll
        for (int ai = 0; ai < 2; ++ai)
#pragma unroll
            for (int m = 0; m < 4; ++m) { const f32x4 g0 = acc[ai][0][m][0], g1 = acc[ai][0][m][1], u0 = acc[ai][1][m][0], u1 = acc[ai][1][m][1];
                u32x4 w; w.x = cvt_pk_bf16(silu_(g0[0]) * u0[0], silu_(g0[1]) * u0[1]); w.y = cvt_pk_bf16(silu_(g0[2]) * u0[2], silu_(g0[3]) * u0[3]);
                w.z = cvt_pk_bf16(silu_(g1[0]) * u1[0], silu_(g1[1]) * u1[1]); w.w = cvt_pk_bf16(silu_(g1[2]) * u1[2], silu_(g1[3]) * u1[3]);
                *(GAS u32x4*)(ACT + (size_t)(row0 + ai * 128 + m * 16) * 512 + ch0) = w; }
    }
};
struct EpiDown {
    static constexpr bool PERM = true;
    bf16_t* CT; const float* roww; const LAS int* tpre;
    __device__ __forceinline__ void operator()(const f32x4 (&acc)[2][2][4][2], const pg8::Unit& u, int wr, int wc, int fr, int fq) const {
        const int lr0 = wr * 64 + fr, col0 = u.pn * 256 + wc * 32 + 8 * fq; const int pos0 = (u.pm - tpre[u.e]) * 256;
#pragma unroll
        for (int ai = 0; ai < 2; ++ai)
#pragma unroll
            for (int m = 0; m < 4; ++m) { const int lr = lr0 + ai * 128 + m * 16; const float wt = lr < u.nvalid ? roww[(size_t)u.e * ECAP + pos0 + lr] : 0.f;
#pragma unroll
                for (int bj = 0; bj < 2; ++bj) { const f32x4 v0 = acc[ai][bj][m][0] * wt, v1 = acc[ai][bj][m][1] * wt;
                    u32x4 w; w.x = cvt_pk_bf16(v0[0], v0[1]); w.y = cvt_pk_bf16(v0[2], v0[3]); w.z = cvt_pk_bf16(v1[0], v1[1]); w.w = cvt_pk_bf16(v1[2], v1[3]);
                    *(GAS u32x4*)(CT + (size_t)(u.pm * 256 + lr) * 1024 + col0 + bj * 128) = w; } }
    }
};

__device__ __forceinline__ void p12_final(Frame& F, const Args& a) {
    LAS int* tpre = (LAS int*)(F.lds + 0); LAS int* cnts = tpre + 64;
    { int nf_; moe_setup(F, tpre, cnts, nullptr, nf_); }
    LAS float* g2 = (LAS float*)(F.lds + 1024);
    LAS float* fg = g2 + 2 * D;
    const float* modv = (const float*)(F.ws + WS_MODV);
    *(LAS f32x4*)(g2 + 4 * F.tid) = *(const GAS f32x4*)(modv + 10 * D + 4 * F.tid);
    if (F.tid < D / 4) *(LAS f32x4*)(fg + 4 * F.tid) = *(const GAS f32x4*)(a.final_g + 4 * F.tid);
    __syncthreads();
    const int* tok_e = (const int*)(F.ws + WS_TOKE); const int* tok_p = (const int*)(F.ws + WS_TOKP); const bf16_t* CT = (const bf16_t*)(F.ws + WS_CONTRIB); const bf16_t* DL = (const bf16_t*)(F.ws + WS_R1);
    const int gw = F.vcu * NWAVES + F.wave, NGW = F.G * NWAVES, lane = F.lane;
    for (int m = gw; m < T; m += 2 * NGW) {
        int mm[2]; mm[0] = m; mm[1] = (m + NGW < T) ? m + NGW : m;
        size_t r0[2], r1[2];
#pragma unroll
        for (int q = 0; q < 2; ++q) { const int e0 = tok_e[mm[q] * 2], e1 = tok_e[mm[q] * 2 + 1]; r0[q] = (size_t)(tpre[e0] * 256 + tok_p[mm[q] * 2]); r1[q] = (size_t)(tpre[e1] * 256 + tok_p[mm[q] * 2 + 1]); }
        f32x4 xv[2][4]; u32x2 pv[2][4], qv[2][4], dv[2][4];
#pragma unroll
        for (int q = 0; q < 2; ++q) { const GAS f32x4* xr = (const GAS f32x4*)(a.x + (size_t)mm[q] * D) + lane; const GAS u32x2* dp = (const GAS u32x2*)(DL + (size_t)mm[q] * D) + lane;
            const GAS u32x2* c0 = (const GAS u32x2*)(CT + r0[q] * 1024) + lane; const GAS u32x2* c1 = (const GAS u32x2*)(CT + r1[q] * 1024) + lane;
#pragma unroll
            for (int j = 0; j < 4; ++j) { xv[q][j] = xr[64 * j]; pv[q][j] = c0[64 * j]; qv[q][j] = c1[64 * j]; dv[q][j] = dp[64 * j]; } }
        f32x4 v[2][4]; float sv[2] = {0.f, 0.f};
#pragma unroll
        for (int q = 0; q < 2; ++q) { const int b = mm[q] / SEQ;
#pragma unroll
            for (int j = 0; j < 4; ++j) { const u32x2 p = pv[q][j], qq = qv[q][j]; const f32x4 g = *(const LAS f32x4*)(g2 + b * D + 256 * j + 4 * lane);
                f32x4 y; y.x = bf_lo(p.x) + bf_lo(qq.x); y.y = bf_hi(p.x) + bf_hi(qq.x); y.z = bf_lo(p.y) + bf_lo(qq.y); y.w = bf_hi(p.y) + bf_hi(qq.y);
                const u32x2 dd = dv[q][j]; v[q][j] = xv[q][j] + (f32x4){bf_lo(dd.x), bf_hi(dd.x), bf_lo(dd.y), bf_hi(dd.y)} + g * y; sv[q] += (v[q][j].x * v[q][j].x + v[q][j].y * v[q][j].y) + (v[q][j].z * v[q][j].z + v[q][j].w * v[q][j].w); } }
#pragma unroll
        for (int o = 1; o < 64; o <<= 1) { sv[0] += __shfl_xor(sv[0], o); sv[1] += __shfl_xor(sv[1], o); }
#pragma unroll
        for (int q = 0; q < 2; ++q) if (q == 0 || mm[1] != mm[0]) { const float rstd = 1.f / sqrtf(sv[q] * (1.f / D) + NORM_EPS);
            GAS f32x4* orow = (GAS f32x4*)(a.out + (size_t)mm[q] * D) + lane;
#pragma unroll
            for (int j = 0; j < 4; ++j) orow[64 * j] = v[q][j] * rstd * *(const LAS f32x4*)(fg + 256 * j + 4 * lane); }
    }
}

__global__ void __launch_bounds__(NTHR, 2) mk_fwd(Args args) {
    extern __shared__ __attribute__((aligned(16))) unsigned char lds_raw[];
    Frame F;
    F.lds = (LAS unsigned char*)lds_raw; F.MISC = (volatile LAS unsigned*)(F.lds + MISC_OFF);
    F.tid = threadIdx.x; F.lane = F.tid & 63; F.wave = __builtin_amdgcn_readfirstlane(F.tid >> 6);
    F.G = gridDim.x; { const int bx = blockIdx.x; F.vcu = (F.G % 8 == 0) ? (bx % 8) * (F.G / 8) + bx / 8 : bx; }
    F.ws = args.ws; F.ctl = (unsigned*)(args.ws + WS_CTL);
    if (F.tid < 64) F.MISC[F.tid] = 0u;
    __syncthreads();
    XcdBarrier bar; bar.bar = F.ctl + CW_BAR; bar.x = 0; bar.st = nullptr;
    if (N_LAUNCHES == 1) bar = xcd_barrier_post(F.ctl + CW_BAR, F.MISC + 8);
    const int lo = args.ph_lo, hi = args.ph_hi;
#define IN(k) (lo <= (k) && (k) < hi)
#define SEAM(k) do { if (IN(k) && IN((k) + 1)) xcd_barrier(bar); } while (0)
    unsigned char* ws = args.ws;

#ifndef PROBE_PH
#define PROBE_PH (-1)
#endif
#define REPS(k) for (int rep_ = 0; rep_ < ((PROBE_PH) == (k) ? 2 : 1); ++rep_)
#define REPBAR(k) do { if ((PROBE_PH) == (k) && rep_ == 0) xcd_barrier(bar); } while (0)
    if (IN(0)) REPS(0) { p0_prologue(F, args); REPBAR(0); } SEAM(0);
    if (IN(1)) { p1_finalize(F, args); } SEAM(1);
    if (IN(2)) REPS(2) { p2_h1_rows(F, args); REPBAR(2); } SEAM(2);
    if (IN(3)) {
        pg8::StaticOrder S; S.init(ws + WS_R1, ws + WS_WIN, T, DIN, D, F.G, (int)blockIdx.x);
        EpiInProj E{(bf16_t*)(ws + WS_Q), (bf16_t*)(ws + WS_K), (bf16_t*)(ws + WS_V), (bf16_t*)(ws + WS_U), (bf16_t*)(ws + WS_BG), (bf16_t*)args.out, (bf16_t*)args.out + (size_t)T * D, args.b_gate};
        pg8::gemm_phase<EpiInProj, pg8::StaticOrder, true, false>(F.lds, D, S, E);
    } SEAM(3);
    if (IN(4)) REPS(4) { p3_kmean(F); REPBAR(4); } SEAM(4);
    if (IN(5)) { p4_topk(F); } SEAM(5);
    if (IN(6)) REPS(6) { p5_attention(F, args); REPBAR(6); } SEAM(6);
    if (IN(7)) REPS(7) { p6_combine_conv(F, args); REPBAR(7); } SEAM(7);
    if (IN(8)) {
        pg8::StaticOrder S; S.init(ws + WS_R1, ws + WS_WAO, T, D, D, F.G, (int)blockIdx.x);
        EpiGateFused E{(bf16_t*)(ws + WS_MERGED), (const bf16_t*)args.out, (const bf16_t*)args.out + (size_t)T * D};
        pg8::gemm_phase<EpiGateFused, pg8::StaticOrder, false, false, false, true>(F.lds, D, S, E);
    } SEAM(8);
    if (IN(9)) {
        pg8::StaticOrder S; S.init(ws + WS_MERGED, ws + WS_WO, T, D, D, F.G, (int)blockIdx.x);
        EpiDelta E{(bf16_t*)(ws + WS_R1), (const float*)(ws + WS_MODV) + 4 * D};
        pg8::gemm_phase<EpiDelta, pg8::StaticOrder, false, false>(F.lds, D, S, E);
    } SEAM(9);
    if (IN(10)) { p9_norm_route(F, args); } SEAM(10);
    if (IN(11)) {
        LAS int* tpre = (LAS int*)(F.lds + MOETAB_OFF); LAS int* cnts = tpre + 64; LAS int* tlist = cnts + 64; LAS int* rowtab = (LAS int*)(F.lds + ROWTAB_OFF);
        int nfull; const int ntiles = moe_setup(F, tpre, cnts, tlist, nfull);
        MoeOrder S{tpre, cnts, tlist, rowtab, (const char*)args.out, (const char*)(ws + WS_WGU), 0, (size_t)1024 * 1024 * 2, (size_t)256 * 1024 * 2, F.G, (int)blockIdx.x, ntiles * 4, nfull * 4};
        { pg8::Unit u; const int* rowidx = (const int*)(ws + WS_ROWIDX);
          for (int i = 0; i < 8 && S.next(i, u); ++i) { if (F.tid < 256) { const int r0 = (u.pm - tpre[u.e]) * 256; rowtab[i * 256 + F.tid] = F.tid < u.nvalid ? rowidx[(size_t)u.e * ECAP + r0 + F.tid] : rowidx[(size_t)u.e * ECAP + r0]; } } }
        __syncthreads();
        EpiSwiglu E{(bf16_t*)(ws + WS_ACT)};
        pg8::gemm_phase<EpiSwiglu, MoeOrder, true, true, true>(F.lds, D, S, E);
    } SEAM(11);
    if (IN(12)) {
        LAS int* tpre = (LAS int*)(F.lds + MOETAB_OFF); LAS int* cnts = tpre + 64; LAS int* tlist = cnts + 64;
        int nfull; const int ntiles = moe_setup(F, tpre, cnts, tlist, nfull);
        MoeOrder S{tpre, cnts, tlist, nullptr, (const char*)(ws + WS_ACT), (const char*)(ws + WS_WD), (size_t)256 * 512 * 2, (size_t)1024 * 512 * 2, (size_t)256 * 512 * 2, F.G, (int)blockIdx.x, ntiles * 4, nfull * 4};
        EpiDown E{(bf16_t*)(ws + WS_CONTRIB), (const float*)(ws + WS_ROWW), tpre};
        pg8::gemm_phase<EpiDown, MoeOrder, true, false, true>(F.lds, DE, S, E);
    } SEAM(12);
    if (IN(13)) { p12_final(F, args); }
#undef REPS
#undef REPBAR
#undef IN
#undef SEAM
}

extern "C" void kernel_launch(void* const* d_in, const int* in_sizes, int n_in, void* d_out, int out_size, void* d_ws, size_t ws_size, hipStream_t stream) {
    static int grid = 0;
    if (grid == 0) {
        if (n_in != 21 || in_sizes[0] != T * D || out_size != T * D || ws_size < WS_END) { fprintf(stderr, "kernel_launch: unexpected shapes (n_in %d, in0 %d, out %d, ws %zu < %zu)\n", n_in, n_in > 0 ? in_sizes[0] : -1, out_size, ws_size, (size_t)WS_END); grid = -1; return; }
        int dev = 0, cus = 0, per_cu = 0;
        if (hipGetDevice(&dev) != hipSuccess || hipDeviceGetAttribute(&cus, hipDeviceAttributeMultiprocessorCount, dev) != hipSuccess) { grid = -1; return; }
        if (hipFuncSetAttribute((const void*)mk_fwd, hipFuncAttributeMaxDynamicSharedMemorySize, LDS_BYTES) != hipSuccess) { fprintf(stderr, "kernel_launch: hipFuncSetAttribute failed\n"); grid = -1; return; }
        if (hipOccupancyMaxActiveBlocksPerMultiprocessor(&per_cu, (const void*)mk_fwd, NTHR, LDS_BYTES) != hipSuccess || per_cu < 1) fprintf(stderr, "kernel_launch: occupancy query reports %d\n", per_cu);
        (void)hipGetLastError();
        grid = cus;
    }
    if (grid < 0) return;
    if (hipMemsetAsync((char*)d_ws + WS_CTL, 0, CTL_ZERO_BYTES, stream) != hipSuccess) return;
    Args a{};
    const float** ap = (const float**)&a;
    for (int i = 0; i < 21; ++i) ap[i] = (const float*)d_in[i];
    a.out = (float*)d_out; a.ws = (unsigned char*)d_ws;
    for (int li = 0; li < N_LAUNCHES; ++li) {
        a.ph_lo = (N_LAUNCHES == 1) ? 0 : li; a.ph_hi = (N_LAUNCHES == 1) ? N_PHASES : li + 1;
        hipLaunchKernelGGL(mk_fwd, dim3(grid), dim3(NTHR), LDS_BYTES, stream, a);
        if (hipPeekAtLastError() != hipSuccess) { fprintf(stderr, "kernel_launch: launch %d failed\n", li); break; }
    }
}
```
